# Optimizing an MI355X kernel written in HIP

```python
import math
import jax, jax.numpy as jnp
from jax import lax
import numpy as np

D_MODEL = 1024
BATCH = 16
SEQ = 2048
DEPTH = 2

CHUNK = 64
Q_BLOCK = 128
D_RNN = 1024
N_RNN_BLOCKS = 8
RNN_BLOCK = D_RNN // N_RNN_BLOCKS
CONV_WIDTH = 4
LRU_C = 8.0
N_HEADS = 16
HEAD_DIM = 64
D_ATTN = N_HEADS * HEAD_DIM
D_FF = 2816
EPS = 1e-6
N_BRANCH = 2
OFF_LRU_X = 0
OFF_LRU_G = OFF_LRU_X + D_RNN
OFF_Q = OFF_LRU_G + D_RNN
OFF_K = OFF_Q + D_ATTN
OFF_V = OFF_K + D_ATTN
OFF_F = OFF_V + D_ATTN
OFF_GATE = OFF_F + N_HEADS
D_IN = OFF_GATE + N_BRANCH * D_MODEL

kernel_name = "hybrid_rglru_fox_macaron_encoder"


def rms_norm(x, g):
    xf = x.astype(jnp.float32)
    y = xf * lax.rsqrt(jnp.mean(xf * xf, axis=-1, keepdims=True) + EPS)
    return (y * g.astype(jnp.float32)).astype(x.dtype)


def swiglu_ffn(h, w_up, w_down):
    gate, up = jnp.split(h @ w_up, 2, axis=-1)
    return (jax.nn.silu(gate) * up) @ w_down


def causal_depthwise_conv(x, w, b):
    y = lax.conv_general_dilated(
        x, w[:, None, :].astype(x.dtype), window_strides=(1,),
        padding=[(CONV_WIDTH - 1, 0)],
        dimension_numbers=("NWC", "WIO", "NWC"),
        feature_group_count=x.shape[-1])
    return y + b


def rg_lru(x, w_a, b_a, w_x, b_x, lam):
    bsz, seq, _ = x.shape
    xb = x.reshape(bsz, seq, N_RNN_BLOCKS, RNN_BLOCK)
    r = jax.nn.sigmoid((jnp.einsum("bsnc,ncd->bsnd", xb, w_a).reshape(bsz, seq, D_RNN) + b_a).astype(jnp.float32))
    i = jax.nn.sigmoid((jnp.einsum("bsnc,ncd->bsnd", xb, w_x).reshape(bsz, seq, D_RNN) + b_x).astype(jnp.float32))
    log_a = -LRU_C * r * jax.nn.softplus(-lam.astype(jnp.float32))
    a = jnp.exp(log_a)
    u = jnp.sqrt(-jnp.expm1(2.0 * log_a)) * (i * x.astype(jnp.float32))

    def combine(left, right):
        a_l, b_l = left
        a_r, b_r = right
        return a_l * a_r, a_r * b_l + b_r

    _, h = lax.associative_scan(combine, (a, u), axis=1)
    return h.astype(x.dtype)


def forgetting_attention(q, k, v, f_logit, g_q, g_k):
    bsz, seq = q.shape[0], q.shape[1]
    qn = rms_norm(q, g_q).transpose(0, 2, 1, 3)
    kn = rms_norm(k, g_k).transpose(0, 2, 1, 3)
    vh = v.transpose(0, 2, 1, 3)
    cum = jnp.cumsum(jax.nn.log_sigmoid(f_logit.astype(jnp.float32)), axis=1).transpose(0, 2, 1)
    scale = HEAD_DIM ** -0.5
    outs = []
    for blk in range(seq // Q_BLOCK):
        q0 = blk * Q_BLOCK
        q1 = q0 + Q_BLOCK
        s = jnp.einsum("bhqd,bhkd->bhqk", qn[:, :, q0:q1], kn[:, :, :q1]).astype(jnp.float32) * scale
        s = s + cum[:, :, q0:q1, None] - cum[:, :, None, :q1]
        mask = jnp.arange(q0, q1)[:, None] >= jnp.arange(q1)[None, :]
        s = jnp.where(mask, s, -jnp.inf)
        p = jax.nn.softmax(s, axis=-1)
        outs.append(jnp.einsum("bhqk,bhkd->bhqd", p.astype(vh.dtype), vh[:, :, :q1]))
    o = jnp.concatenate(outs, axis=2)
    return o.transpose(0, 2, 1, 3).reshape(bsz, seq, D_ATTN)


def setup_inputs(seed: int = 0) -> dict:
    key = jax.random.key(seed)
    ks = jax.random.split(key, 24)
    L, D, F = DEPTH, D_MODEL, D_FF
    nrm = lambda k, shape, fan_in: jax.random.normal(k, shape, jnp.float32) * (fan_in ** -0.5)
    gain = lambda k, shape: 1.0 + 0.02 * jax.random.normal(k, shape, jnp.float32)
    small = lambda k, shape: 0.01 * jax.random.normal(k, shape, jnp.float32)
    u = jax.random.uniform(ks[13], (L, D_RNN), jnp.float32, 0.9, 0.999)
    a0 = u ** (1.0 / LRU_C)
    lam = jnp.log(a0) - jnp.log1p(-a0)
    return {
        "x": jax.random.normal(ks[0], (BATCH, SEQ, D), jnp.float32),
        "g_ffn1": gain(ks[1], (L, D)),
        "w_up1": nrm(ks[2], (L, D, 2 * F), D),
        "w_down1": nrm(ks[3], (L, F, D), F),
        "g_mix": gain(ks[4], (L, D)),
        "w_in": nrm(ks[5], (L, D, D_IN), D),
        "b_gate": small(ks[6], (L, N_BRANCH * D)),
        "conv_w": nrm(ks[7], (L, CONV_WIDTH, D_RNN), CONV_WIDTH),
        "conv_b": small(ks[8], (L, D_RNN)),
        "w_a": nrm(ks[9], (L, N_RNN_BLOCKS, RNN_BLOCK, RNN_BLOCK), RNN_BLOCK),
        "b_a": small(ks[10], (L, D_RNN)),
        "w_x": nrm(ks[11], (L, N_RNN_BLOCKS, RNN_BLOCK, RNN_BLOCK), RNN_BLOCK),
        "b_x": small(ks[12], (L, D_RNN)),
        "lam": lam,
        "g_q": gain(ks[14], (L, HEAD_DIM)),
        "g_k": gain(ks[15], (L, HEAD_DIM)),
        "b_forget": jax.random.uniform(ks[16], (L, N_HEADS), jnp.float32, 1.0, 6.0),
        "w_lru_out": nrm(ks[17], (L, D_RNN, D), D_RNN),
        "w_attn_out": nrm(ks[18], (L, D_ATTN, D), D_ATTN),
        "w_o": nrm(ks[19], (L, D, D), D),
        "g_ffn2": gain(ks[20], (L, D)),
        "w_up2": nrm(ks[21], (L, D, 2 * F), D),
        "w_down2": nrm(ks[22], (L, F, D), F),
    }


def reference(x, g_ffn1, w_up1, w_down1, g_mix, w_in, b_gate, conv_w, conv_b,
              w_a, b_a, w_x, b_x, lam, g_q, g_k, b_forget, w_lru_out, w_attn_out,
              w_o, g_ffn2, w_up2, w_down2):
    bsz, seq, _ = x.shape
    assert seq % CHUNK == 0 and seq % Q_BLOCK == 0
    for l in range(DEPTH):
        x = x + 0.5 * swiglu_ffn(rms_norm(x, g_ffn1[l]), w_up1[l], w_down1[l])

        h = rms_norm(x, g_mix[l])
        z = h @ w_in[l]
        z_lx = z[..., OFF_LRU_X:OFF_LRU_G]
        z_lg = z[..., OFF_LRU_G:OFF_Q]
        q = z[..., OFF_Q:OFF_K].reshape(bsz, seq, N_HEADS, HEAD_DIM)
        k = z[..., OFF_K:OFF_V].reshape(bsz, seq, N_HEADS, HEAD_DIM)
        v = z[..., OFF_V:OFF_F].reshape(bsz, seq, N_HEADS, HEAD_DIM)
        f_logit = z[..., OFF_F:OFF_GATE] + b_forget[l]
        gates = jax.nn.sigmoid(z[..., OFF_GATE:] + b_gate[l])
        gate_lru, gate_attn = jnp.split(gates, N_BRANCH, axis=-1)

        xr = causal_depthwise_conv(z_lx, conv_w[l], conv_b[l])
        hr = rg_lru(xr, w_a[l], b_a[l], w_x[l], b_x[l], lam[l])
        y_lru = (jax.nn.gelu(z_lg) * hr) @ w_lru_out[l]

        o = forgetting_attention(q, k, v, f_logit, g_q[l], g_k[l])
        y_attn = o @ w_attn_out[l]

        m = gate_lru * y_lru + gate_attn * y_attn
        x = x + m @ w_o[l]

        x = x + 0.5 * swiglu_ffn(rms_norm(x, g_ffn2[l]), w_up2[l], w_down2[l])
    return x
```

```cpp
#include <hip/hip_runtime.h>
#include <hip/hip_cooperative_groups.h>
#include <cstdio>
#include <cstdint>
namespace cg = cooperative_groups;
namespace pg8 {
#define PG8_LAS __attribute__((address_space(3)))
typedef unsigned short bf16_t;
typedef short bf16x8 __attribute__((ext_vector_type(8)));
typedef float f32x4 __attribute__((ext_vector_type(4)));
typedef unsigned u32x4 __attribute__((ext_vector_type(4)));
constexpr int BM = 256, BK = 64, HALF = 128, HTB = HALF * BK * 2  , STAGE_BYTES = 8 * HTB, NXCD = 8, WGM = 8;

__host__ __device__ __forceinline__ int lds_byte(int r, int c) { const int st = (r >> 4) * 2 + (c >> 5), rr = r & 15, cc = c & 31, ob = rr * 64 + cc * 2; return st * 1024 + (ob ^ (((ob >> 9) & 1) << 5)); }
__host__ __device__ __forceinline__ void stage_rc(int b, int& R, int& C) { const int st = b / 1024, sb = b % 1024, swz = sb ^ (((sb >> 9) & 1) << 5); R = (st >> 1) * 16 + swz / 64; C = (st & 1) * 32 + (swz % 64) / 2; }
__host__ __device__ __forceinline__ int perm32(int rho) { const int n = rho >> 4, i = rho & 15; return 8 * (i >> 2) + 4 * n + (i & 3); }

struct Unit { int pm, pn, part; };
struct Gemm { const bf16_t *A0, *A1, *A2, *A3, *B0, *B1, *B2, *B3; int K; };
__device__ __forceinline__ const char* selA(const Gemm& g, int p) { return (const char*)(p == 0 ? g.A0 : p == 1 ? g.A1 : p == 2 ? g.A2 : g.A3); }
__device__ __forceinline__ const char* selB(const Gemm& g, int p) { return (const char*)(p == 0 ? g.B0 : p == 1 ? g.B1 : p == 2 ? g.B2 : g.B3); }

struct StaticOrder {
    int nM, nN, nwg, G, c, np;
    __host__ __device__ void init(int M, int N, int G_, int c_, int np_) { nM = M / BM; nN = N / BM; nwg = nM * nN; G = G_; c = c_; np = np_; }
    __host__ __device__ bool next(int i, Unit& u) const {
        const int it = i / np; u.part = i - it * np;
        const long L = (long)it * G + c; if (L >= nwg) return false;
        int wgid = (int)L; { const int q = nwg / NXCD, r = nwg % NXCD, xcd = wgid % NXCD, off = wgid / NXCD; wgid = (xcd < r ? xcd * (q + 1) : r * (q + 1) + (xcd - r) * q) + off; }
        const int nig = WGM * nN, gid = wgid / nig, fm = gid * WGM, gsz = (nM - fm) < WGM ? (nM - fm) : WGM;
        u.pm = fm + ((wgid % nig) % gsz); u.pn = (wgid % nig) / gsz; return true;
    }
    __device__ __forceinline__ void a_ready(const Unit&) const {}
    __device__ __forceinline__ void done(const Unit&) const {}
};

typedef float f32x2 __attribute__((ext_vector_type(2))); typedef __bf16 bf16x2v __attribute__((ext_vector_type(2)));
__device__ __forceinline__ unsigned cvt_pk_bf16(float lo, float hi) { const f32x2 v = {lo, hi}; const bf16x2v b = __builtin_convertvector(v, bf16x2v); return __builtin_bit_cast(unsigned, b); }
__device__ __forceinline__ f32x2 gelu_pk(f32x2 v) {
    const f32x2 av = __builtin_elementwise_abs(v), d = av * 0.2316418882f + 1.0f;
    f32x2 t; t.x = __builtin_amdgcn_rcpf(d.x); t.y = __builtin_amdgcn_rcpf(d.y);
    f32x2 q = t * 0.5307027145f + (-0.7265760135f); q = q * t + 0.7107068705f; q = q * t + (-0.142248368f); q = q * t + 0.127414796f; q = q * t;
    const f32x2 s = (v * v) * (-0.72134752044f);
    f32x2 e; e.x = __builtin_amdgcn_exp2f(s.x); e.y = __builtin_amdgcn_exp2f(s.y);
    const f32x2 m = v * (q * e), r = v - m;
    f32x2 o; o.x = v.x < 0.f ? m.x : r.x; o.y = v.y < 0.f ? m.y : r.y; return o;
}
constexpr float kLog2e = 1.4426950408889634f;
__device__ __forceinline__ float sigm(float x) { return __builtin_amdgcn_rcpf(1.0f + __builtin_amdgcn_exp2f(-kLog2e * x)); }
__device__ __forceinline__ float gelu_tanh(float x) { const float u = x * (1.0f + 0.044715f * x * x); return x * sigm(1.5957691216057308f * u); }
__device__ __forceinline__ void st8(bf16_t* p, const f32x4 a, const f32x4 b) { u32x4 w; w.x = cvt_pk_bf16(a[0], a[1]); w.y = cvt_pk_bf16(a[2], a[3]); w.z = cvt_pk_bf16(b[0], b[1]); w.w = cvt_pk_bf16(b[2], b[3]); *(u32x4*)p = w; }
__device__ __forceinline__ u32x4 ldg16_l2(const void* p) { const unsigned long long lo = __hip_atomic_load((const unsigned long long*)p, __ATOMIC_RELAXED, __HIP_MEMORY_SCOPE_AGENT), hi = __hip_atomic_load((const unsigned long long*)p + 1, __ATOMIC_RELAXED, __HIP_MEMORY_SCOPE_AGENT);
    u32x4 w; w.x = (unsigned)lo; w.y = (unsigned)(lo >> 32); w.z = (unsigned)hi; w.w = (unsigned)(hi >> 32); return w; }
__device__ __forceinline__ void unpk8(const u32x4 w, f32x4& a, f32x4& b) {
    a[0] = __uint_as_float(w.x << 16); a[1] = __uint_as_float(w.x & 0xffff0000u); a[2] = __uint_as_float(w.y << 16); a[3] = __uint_as_float(w.y & 0xffff0000u);
    b[0] = __uint_as_float(w.z << 16); b[1] = __uint_as_float(w.z & 0xffff0000u); b[2] = __uint_as_float(w.w << 16); b[3] = __uint_as_float(w.w & 0xffff0000u); }
__device__ __forceinline__ void ld8(const bf16_t* p, f32x4& a, f32x4& b) { const u32x4 w = *(const u32x4*)p;
    a[0] = __uint_as_float(w.x << 16); a[1] = __uint_as_float(w.x & 0xffff0000u); a[2] = __uint_as_float(w.y << 16); a[3] = __uint_as_float(w.y & 0xffff0000u);
    b[0] = __uint_as_float(w.z << 16); b[1] = __uint_as_float(w.z & 0xffff0000u); b[2] = __uint_as_float(w.w << 16); b[3] = __uint_as_float(w.w & 0xffff0000u); }
constexpr int RSQ_ROWS = 32768;
struct Rs8 { float v[2][4]; };
__device__ __forceinline__ Rs8 load_rstd8(const float* rowsq, int pm, int wr, int fr, int fq) { Rs8 r; f32x4 t[2][4];
    _Pragma("unroll") for (int ai = 0; ai < 2; ++ai) _Pragma("unroll") for (int m = 0; m < 4; ++m) t[ai][m] = *(const f32x4*)(rowsq + (size_t)(pm * BM + ai * HALF + wr * 64 + m * 16 + fr) * 16 + 4 * fq);
    const int ln = fq * 16 + fr;
    _Pragma("unroll") for (int ai = 0; ai < 2; ++ai) _Pragma("unroll") for (int m = 0; m < 4; ++m) { float s = (t[ai][m][0] + t[ai][m][1]) + (t[ai][m][2] + t[ai][m][3]);
        s += __builtin_bit_cast(float, __builtin_amdgcn_ds_bpermute((ln ^ 16) << 2, __builtin_bit_cast(int, s))); s += __builtin_bit_cast(float, __builtin_amdgcn_ds_bpermute((ln ^ 32) << 2, __builtin_bit_cast(int, s)));
        r.v[ai][m] = __builtin_amdgcn_rsqf(s * (1.0f / 1024.0f) + 1e-6f); }
    return r; }
__device__ __forceinline__ Rs8 load_rstd8_direct(const float* rstd, int pm, int wr, int fr) { Rs8 r;
    _Pragma("unroll") for (int ai = 0; ai < 2; ++ai) _Pragma("unroll") for (int m = 0; m < 4; ++m) r.v[ai][m] = rstd[pm * BM + ai * HALF + wr * 64 + m * 16 + fr];
    return r; }
__device__ __forceinline__ float bperm(int srclane, float v) { return __builtin_bit_cast(float, __builtin_amdgcn_ds_bpermute(srclane << 2, __builtin_bit_cast(int, v))); }
#define EPI_ROWS(...) _Pragma("unroll") for (int ai = 0; ai < 2; ++ai) _Pragma("unroll") for (int m = 0; m < 4; ++m) { const int row = u.pm * BM + ai * HALF + wr * 64 + m * 16 + fr; __VA_ARGS__ }

struct EpiUp {
    static constexpr bool PERM = true, AFTER_DRAIN = false;
    bf16_t* O; const float* rowsq;
    __device__ __forceinline__ void operator()(const f32x4 (&acc)[2][2][4][2], const Unit& u, int wr, int wc, int fr, int fq) const {
        const int col = u.pn * 128 + wc * 32 + 8 * fq; const Rs8 R = load_rstd8(rowsq, u.pm, wr, fr, fq);
        EPI_ROWS(
            const float rs = R.v[ai][m];
            f32x4 o[2];
            _Pragma("unroll") for (int n = 0; n < 2; ++n) { const f32x4 g = acc[ai][0][m][n] * rs, up = acc[ai][1][m][n] * rs;
                _Pragma("unroll") for (int j = 0; j < 4; ++j) o[n][j] = g[j] * sigm(g[j]) * up[j]; }
            st8(O + (size_t)row * 2816 + col, o[0], o[1]);
        )
    }
};
struct EpiRes {
    static constexpr bool PERM = true, AFTER_DRAIN = false;
    const float* base; float* out; bf16_t* xb; float* rsq_next; float scale;
    __device__ __forceinline__ void operator()(const f32x4 (&acc)[2][2][4][2], const Unit& u, int wr, int wc, int fr, int fq) const {
        const int col = u.pn * BM + wc * 32 + 8 * fq;
#pragma unroll
        for (int ai = 0; ai < 2; ++ai) { f32x4 bs[4][2][2];
#pragma unroll
            for (int m = 0; m < 4; ++m)
#pragma unroll
                for (int bj = 0; bj < 2; ++bj) { const size_t off = (size_t)(u.pm * BM + ai * HALF + wr * 64 + m * 16 + fr) * 1024 + col + bj * HALF; bs[m][bj][0] = *(const f32x4*)(base + off); bs[m][bj][1] = *(const f32x4*)(base + off + 4); }
#pragma unroll
            for (int m = 0; m < 4; ++m) { const int row = u.pm * BM + ai * HALF + wr * 64 + m * 16 + fr; float ss = 0.f;
#pragma unroll
                for (int bj = 0; bj < 2; ++bj) { const size_t off = (size_t)row * 1024 + col + bj * HALF;
                    const f32x4 o0 = bs[m][bj][0] + acc[ai][bj][m][0] * scale, o1 = bs[m][bj][1] + acc[ai][bj][m][1] * scale;
                    *(f32x4*)(out + off) = o0; *(f32x4*)(out + off + 4) = o1;
                    ss += (o0[0] * o0[0] + o0[1] * o0[1]) + (o0[2] * o0[2] + o0[3] * o0[3]) + (o1[0] * o1[0] + o1[1] * o1[1]) + (o1[2] * o1[2] + o1[3] * o1[3]);
                    if (xb) st8(xb + off, o0, o1); }
                if (rsq_next) { const int ln = fq * 16 + fr; ss += bperm(ln ^ 16, ss); ss += bperm(ln ^ 32, ss); if (fq == 0) rsq_next[(size_t)row * 16 + u.pn * 4 + wc] = ss; } }
            asm volatile("" ::: "memory"); }
    }
};
struct EpiZ {
    static constexpr bool PERM = true, AFTER_DRAIN = false;
    bf16_t *ZLX, *G, *Q, *Kb, *V; float* logf; const float* rowsq; const float *gq, *gk, *bforget; float c2; float* rstd2;
    __device__ __forceinline__ void operator()(const f32x4 (&acc)[2][2][4][2], const Unit& u, int wr, int wc, int fr, int fq) const {
        const int t = u.pn >> 2, pnl = u.pn & 3; const Rs8 R = load_rstd8(rowsq, u.pm, wr, fr, fq);
        if (t == 0 || t == 4) { bf16_t* O = t == 0 ? ZLX : V; const int col = pnl * BM + wc * 32 + 8 * fq;
            EPI_ROWS( const float rs = R.v[ai][m];
                _Pragma("unroll") for (int bj = 0; bj < 2; ++bj) st8(O + (size_t)row * 1024 + col + bj * HALF, acc[ai][bj][m][0] * rs, acc[ai][bj][m][1] * rs); )
        } else if (t == 1) { const int col = pnl * BM + wc * 32 + 8 * fq;
            EPI_ROWS( const float rs = R.v[ai][m];
                _Pragma("unroll") for (int bj = 0; bj < 2; ++bj) { f32x4 o[2];
                    _Pragma("unroll") for (int n = 0; n < 2; ++n) _Pragma("unroll") for (int j = 0; j < 4; ++j) o[n][j] = gelu_tanh(acc[ai][bj][m][n][j] * rs);
                    st8(G + (size_t)row * 1024 + col + bj * HALF, o[0], o[1]); } )
        } else if (t == 2 || t == 3) {
            bf16_t* O = t == 2 ? Q : Kb; const float* gn = t == 2 ? gq : gk; const float sc = t == 2 ? c2 : 1.0f;
            const int col = (pnl * 4 + wc) * 64 + 8 * fq;
            f32x4 gv[2][2];
            _Pragma("unroll") for (int bj = 0; bj < 2; ++bj) _Pragma("unroll") for (int n = 0; n < 2; ++n) gv[bj][n] = *(const f32x4*)(gn + 32 * bj + 8 * fq + 4 * n) * sc;
            EPI_ROWS( const float rs = R.v[ai][m];
                f32x4 v[2][2]; float ss = 0.f;
                _Pragma("unroll") for (int bj = 0; bj < 2; ++bj) _Pragma("unroll") for (int n = 0; n < 2; ++n) { v[bj][n] = acc[ai][bj][m][n] * rs; const f32x4 q = v[bj][n] * v[bj][n]; ss += (q[0] + q[1]) + (q[2] + q[3]); }
                { const int ln = fq * 16 + fr; ss += bperm(ln ^ 16, ss); ss += bperm(ln ^ 32, ss); }
                const float rn = __builtin_amdgcn_rsqf(ss * (1.0f / 64.0f) + 1e-6f);
                _Pragma("unroll") for (int bj = 0; bj < 2; ++bj) st8(O + (size_t)row * 1024 + col + 32 * bj, v[bj][0] * rn * gv[bj][0], v[bj][1] * rn * gv[bj][1]); )
        } else {
            if (wc == 0 && fq < 2) {
                f32x4 bf0 = *(const f32x4*)(bforget + 8 * fq), bf1 = *(const f32x4*)(bforget + 8 * fq + 4);
                EPI_ROWS( const float rs = R.v[ai][m]; f32x4 o[2];
                    _Pragma("unroll") for (int n = 0; n < 2; ++n) _Pragma("unroll") for (int j = 0; j < 4; ++j) { const float x = acc[ai][0][m][n][j] * rs + (n == 0 ? bf0[j] : bf1[j]);
                        o[n][j] = fminf(x, 0.f) - log1pf(__expf(-fabsf(x))); }
                    *(f32x4*)(logf + (size_t)row * 16 + 8 * fq) = o[0]; *(f32x4*)(logf + (size_t)row * 16 + 8 * fq + 4) = o[1]; if (fq == 0) rstd2[row] = rs; )
            }
        }
    }
};
struct EpiMerge {
    static constexpr bool PERM = true, AFTER_DRAIN = false;
    bf16_t *GA, *GB, *MB; const float* rstd2; const float* bgate;
    __device__ __forceinline__ void operator()(const f32x4 (&acc)[2][2][4][2], const Unit& u, int wr, int wc, int fr, int fq) const {
        const int col = u.pn * BM + wc * 32 + 8 * fq;
        if (u.part < 2) { bf16_t* O = u.part == 0 ? GA : GB; const float* bg = bgate + u.part * 1024 + col;
            f32x4 bv[2][2];
            _Pragma("unroll") for (int bj = 0; bj < 2; ++bj) _Pragma("unroll") for (int n = 0; n < 2; ++n) bv[bj][n] = *(const f32x4*)(bg + bj * HALF + 4 * n);
            const Rs8 R = load_rstd8_direct(rstd2, u.pm, wr, fr);
            EPI_ROWS( const float rs = R.v[ai][m];
                _Pragma("unroll") for (int bj = 0; bj < 2; ++bj) { f32x4 o[2];
                    _Pragma("unroll") for (int n = 0; n < 2; ++n) _Pragma("unroll") for (int j = 0; j < 4; ++j) o[n][j] = acc[ai][bj][m][n][j] * rs + bv[bj][n][j];
                    st8(O + (size_t)row * 1024 + col + bj * HALF, o[0], o[1]); } )
        } else if (u.part == 2) { u32x4 gw[2][4][2];
#pragma unroll
            for (int ai = 0; ai < 2; ++ai)
#pragma unroll
                for (int m = 0; m < 4; ++m)
#pragma unroll
                    for (int bj = 0; bj < 2; ++bj) gw[ai][m][bj] = *(const u32x4*)(GA + (size_t)(u.pm * BM + ai * HALF + wr * 64 + m * 16 + fr) * 1024 + col + bj * HALF);
            EPI_ROWS( _Pragma("unroll") for (int bj = 0; bj < 2; ++bj) { const size_t off = (size_t)row * 1024 + col + bj * HALF; f32x4 g0, g1; unpk8(gw[ai][m][bj], g0, g1);
                    _Pragma("unroll") for (int j = 0; j < 4; ++j) { g0[j] = sigm(g0[j]); g1[j] = sigm(g1[j]); }
                    st8(MB + off, g0 * acc[ai][bj][m][0], g1 * acc[ai][bj][m][1]); } )
        } else {
#pragma unroll
            for (int ai = 0; ai < 2; ++ai) { u32x4 gw[4][2], mw[4][2];
#pragma unroll
                for (int m = 0; m < 4; ++m)
#pragma unroll
                    for (int bj = 0; bj < 2; ++bj) { const size_t off = (size_t)(u.pm * BM + ai * HALF + wr * 64 + m * 16 + fr) * 1024 + col + bj * HALF; gw[m][bj] = *(const u32x4*)(GB + off); mw[m][bj] = *(const u32x4*)(MB + off); }
#pragma unroll
                for (int m = 0; m < 4; ++m)
#pragma unroll
                    for (int bj = 0; bj < 2; ++bj) { const size_t off = (size_t)(u.pm * BM + ai * HALF + wr * 64 + m * 16 + fr) * 1024 + col + bj * HALF; f32x4 g0, g1, m0, m1; unpk8(gw[m][bj], g0, g1); unpk8(mw[m][bj], m0, m1);
                        _Pragma("unroll") for (int j = 0; j < 4; ++j) { g0[j] = sigm(g0[j]); g1[j] = sigm(g1[j]); }
                        st8(MB + off, m0 + g0 * acc[ai][bj][m][0], m1 + g1 * acc[ai][bj][m][1]); }
                asm volatile("" ::: "memory"); }
        }
    }
};
template <class Epi, class Sched, bool ALIGN_EPI = false, bool SP2 = false>
__device__ __forceinline__ void gemm_phase(PG8_LAS unsigned char* lds, const Gemm g, const Sched& S, const Epi& E, const int tid) {
    const int wid = __builtin_amdgcn_readfirstlane(tid >> 6), lane = tid & 63, wr = wid >> 2, wc = wid & 3, fr = lane & 15, fq = lane >> 4;
    const int K = g.K, nt = K / BK;
    unsigned voffA[2], voffB[2];
#pragma unroll
    for (int i = 0; i < 2; ++i) { int R, C; stage_rc(tid * 16 + i * 8192, R, C); const int Rb = Epi::PERM ? ((R & ~31) + perm32(R & 31)) : R;
        voffA[i] = (unsigned)(R * K + C) * 2u; voffB[i] = (unsigned)(Rb * K + C) * 2u; }
    const size_t kstep = (size_t)(BK * 2);
    const size_t hstep = (size_t)HALF * K * 2;
    const size_t tstep = 2 * hstep;
    const unsigned ldsw = (unsigned)wid * 1024u;
    const int aoff = lds_byte(wr * 64 + fr, fq * 8), boff = lds_byte(wc * 32 + fr, fq * 8);
#define PG8_SA(b, h) (((b) * 2 + (h)) * HTB)
#define PG8_SB(b, h) ((4 + (b) * 2 + (h)) * HTB)
#define PG8_STAGE(bufoff, gbase, voff) do { _Pragma("unroll") for (int _i = 0; _i < 2; ++_i) \
        __builtin_amdgcn_global_load_lds((const unsigned*)((const char*)(gbase) + (voff)[_i]), (PG8_LAS unsigned*)(lds + (bufoff) + ldsw + _i * 8192), 16, 0, 0); } while (0)
#define PG8_LDA(dst, b, h) do { _Pragma("unroll") for (int m = 0; m < 4; ++m) _Pragma("unroll") for (int k = 0; k < 2; ++k) dst[m][k] = *(const PG8_LAS bf16x8*)(lds + PG8_SA(b, h) + aoff + m * 2048 + k * 1024); } while (0)
#define PG8_LDB(dst, b, h) do { _Pragma("unroll") for (int n = 0; n < 2; ++n) _Pragma("unroll") for (int k = 0; k < 2; ++k) dst[n][k] = *(const PG8_LAS bf16x8*)(lds + PG8_SB(b, h) + boff + n * 2048 + k * 1024); } while (0)
#define PG8_MMA(ai, bj, At, Bt) do { __builtin_amdgcn_s_setprio(1); _Pragma("unroll") for (int m = 0; m < 4; ++m) _Pragma("unroll") for (int n = 0; n < 2; ++n) _Pragma("unroll") for (int k = 0; k < 2; ++k) \
        acc[ai][bj][m][n] = __builtin_amdgcn_mfma_f32_16x16x32_bf16(Bt[n][k], At[m][k], acc[ai][bj][m][n], 0, 0, 0); __builtin_amdgcn_s_setprio(0); } while (0)
#define PG8_WAIT_V(n) asm volatile("s_waitcnt vmcnt(" #n ")" ::: "memory")
#define PG8_WAIT_L(n) asm volatile("s_waitcnt lgkmcnt(" #n ")" ::: "memory")
#define PG8_BAR __builtin_amdgcn_s_barrier()
#define PG8_SCHED __builtin_amdgcn_sched_barrier(0)
    Unit cur, nxt; int ui = 0;
    if (!S.next(0, cur)) return;
    f32x4 acc[2][2][4][2];
#pragma unroll
    for (int a = 0; a < 2; ++a)
#pragma unroll
        for (int b = 0; b < 2; ++b)
#pragma unroll
            for (int m = 0; m < 4; ++m)
#pragma unroll
                for (int n = 0; n < 2; ++n) acc[a][b][m][n] = (f32x4){0.f, 0.f, 0.f, 0.f};
    bf16x8 At[4][2], B0[2][2], B1[2][2];
    const char* cA = selA(g, cur.part) + (size_t)cur.pm * tstep; const char* cB = selB(g, cur.part) + (size_t)cur.pn * tstep;
    S.a_ready(cur);
    if constexpr (SP2) {
        PG8_STAGE(PG8_SB(0, 0), cB, voffB); PG8_STAGE(PG8_SB(0, 1), cB + hstep, voffB); PG8_STAGE(PG8_SA(0, 0), cA, voffA); PG8_STAGE(PG8_SA(0, 1), cA + hstep, voffA);
        if (wr == 1) PG8_BAR;
        PG8_WAIT_V(2); PG8_BAR;
        PG8_STAGE(PG8_SB(1, 0), cB + kstep, voffB); PG8_STAGE(PG8_SA(1, 0), cA + kstep, voffA); PG8_STAGE(PG8_SB(1, 1), cB + hstep + kstep, voffB);
        PG8_WAIT_V(6); PG8_BAR;
    } else {
        PG8_STAGE(PG8_SB(0, 0), cB, voffB); PG8_STAGE(PG8_SA(0, 0), cA, voffA); PG8_STAGE(PG8_SB(0, 1), cB + hstep, voffB); PG8_STAGE(PG8_SA(0, 1), cA + hstep, voffA);
        if (wr == 1) PG8_BAR;
        PG8_WAIT_V(4); PG8_BAR;
        PG8_STAGE(PG8_SB(1, 0), cB + kstep, voffB); PG8_STAGE(PG8_SA(1, 0), cA + kstep, voffA); PG8_STAGE(PG8_SB(1, 1), cB + hstep + kstep, voffB);
        PG8_WAIT_V(6); PG8_BAR;
    }
    for (;;) {
        const bool has_next = S.next(ui + 1, nxt);
        const char* nA = has_next ? selA(g, nxt.part) + (size_t)nxt.pm * tstep : cA; const char* nB = has_next ? selB(g, nxt.part) + (size_t)nxt.pn * tstep : cB;
        for (int t = 0; t < nt; t += 2) {
            const bool last = (t == nt - 2);
            const char* a1 = cA + (size_t)(t + 1) * kstep;
            const char* a2 = last ? nA : cA + (size_t)(t + 2) * kstep; const char* b2 = last ? nB : cB + (size_t)(t + 2) * kstep;
            const char* a3 = a2 + kstep; const char* b3 = b2 + kstep;
            if (last && has_next) S.a_ready(nxt);
            if constexpr (SP2) {
            PG8_LDB(B0, 0, 0); PG8_LDB(B1, 0, 1); PG8_SCHED; PG8_LDA(At, 0, 0); PG8_STAGE(PG8_SA(1, 1), a1 + hstep, voffA);
            PG8_WAIT_V(8); PG8_WAIT_L(0); PG8_BAR; PG8_MMA(0, 0, At, B0); PG8_MMA(0, 1, At, B1); PG8_BAR; PG8_SCHED;
            PG8_LDA(At, 0, 1); PG8_STAGE(PG8_SB(0, 0), b2, voffB); PG8_STAGE(PG8_SB(0, 1), b2 + hstep, voffB); PG8_STAGE(PG8_SA(0, 0), a2, voffA);
            PG8_WAIT_V(8); PG8_WAIT_L(0); PG8_BAR; PG8_MMA(1, 0, At, B0); PG8_MMA(1, 1, At, B1); PG8_BAR; PG8_SCHED;
            PG8_LDB(B0, 1, 0); PG8_LDB(B1, 1, 1); PG8_SCHED; PG8_LDA(At, 1, 0); PG8_STAGE(PG8_SA(0, 1), a2 + hstep, voffA);
            PG8_WAIT_V(8); PG8_WAIT_L(0); PG8_BAR; PG8_MMA(0, 0, At, B0); PG8_MMA(0, 1, At, B1); PG8_BAR; PG8_SCHED;
            PG8_LDA(At, 1, 1); PG8_STAGE(PG8_SB(1, 0), b3, voffB); PG8_STAGE(PG8_SB(1, 1), b3 + hstep, voffB); PG8_STAGE(PG8_SA(1, 0), a3, voffA);
            PG8_WAIT_V(8); PG8_WAIT_L(0); PG8_BAR; PG8_MMA(1, 0, At, B0); PG8_MMA(1, 1, At, B1); PG8_BAR; PG8_SCHED;
            } else {
            PG8_LDB(B0, 0, 0); PG8_SCHED; PG8_LDA(At, 0, 0); PG8_STAGE(PG8_SA(1, 1), a1 + hstep, voffA);
            PG8_WAIT_L(8); PG8_BAR; PG8_WAIT_L(0); PG8_MMA(0, 0, At, B0); PG8_BAR; PG8_SCHED;
            PG8_LDB(B1, 0, 1); PG8_STAGE(PG8_SB(0, 0), b2, voffB);
            PG8_BAR; PG8_WAIT_L(0); PG8_MMA(0, 1, At, B1); PG8_BAR;
            PG8_LDA(At, 0, 1); PG8_STAGE(PG8_SA(0, 0), a2, voffA);
            PG8_BAR; PG8_WAIT_L(0); PG8_MMA(1, 0, At, B0); PG8_BAR; PG8_SCHED;
            PG8_STAGE(PG8_SB(0, 1), b2 + hstep, voffB);
            PG8_WAIT_V(6); PG8_BAR; PG8_MMA(1, 1, At, B1); PG8_BAR;
            PG8_LDB(B0, 1, 0); PG8_SCHED; PG8_LDA(At, 1, 0); PG8_STAGE(PG8_SA(0, 1), a2 + hstep, voffA);
            PG8_WAIT_L(8); PG8_BAR; PG8_WAIT_L(0); PG8_MMA(0, 0, At, B0); PG8_BAR; PG8_SCHED;
            PG8_LDB(B1, 1, 1); PG8_STAGE(PG8_SB(1, 0), b3, voffB);
            PG8_BAR; PG8_WAIT_L(0); PG8_MMA(0, 1, At, B1); PG8_BAR;
            PG8_LDA(At, 1, 1); PG8_STAGE(PG8_SA(1, 0), a3, voffA);
            PG8_BAR; PG8_WAIT_L(0); PG8_MMA(1, 0, At, B0); PG8_BAR; PG8_SCHED;
            PG8_STAGE(PG8_SB(1, 1), b3 + hstep, voffB);
            PG8_WAIT_V(6); PG8_BAR; PG8_MMA(1, 1, At, B1); PG8_BAR;
            }
        }
        if constexpr (ALIGN_EPI) { if (wr == 0) PG8_BAR; }
        if constexpr (!Epi::AFTER_DRAIN) { E(acc, cur, wr, wc, fr, fq); S.done(cur); }
        if (!has_next) break;
#pragma unroll
        for (int a = 0; a < 2; ++a)
#pragma unroll
            for (int b = 0; b < 2; ++b)
#pragma unroll
                for (int m = 0; m < 4; ++m)
#pragma unroll
                    for (int n = 0; n < 2; ++n) acc[a][b][m][n] = (f32x4){0.f, 0.f, 0.f, 0.f};
        cur = nxt; cA = nA; cB = nB; ++ui;
        if constexpr (ALIGN_EPI) { if (wr == 1) PG8_BAR; }
    }
    PG8_WAIT_V(0);
    if constexpr (!ALIGN_EPI) { if (wr == 0) PG8_BAR; }
    PG8_BAR;
    if constexpr (Epi::AFTER_DRAIN) { E.fused(acc, cur, wr, wc, fr, fq, lds, wid, lane); S.done(cur); }
#undef PG8_SA
#undef PG8_SB
#undef PG8_STAGE
#undef PG8_LDA
#undef PG8_LDB
#undef PG8_MMA
#undef PG8_WAIT_V
#undef PG8_WAIT_L
#undef PG8_BAR
#undef PG8_SCHED
}
}

#include <hip/hip_bf16.h>
#include <cmath>
namespace attn_body {
using bf16=__hip_bfloat16;
using bf16x8=__attribute__((ext_vector_type(8)))short;
using s16x4=__attribute__((ext_vector_type(4)))short;
using f32x16=__attribute__((ext_vector_type(16)))float;
using u32x4=__attribute__((ext_vector_type(4)))unsigned;
using f32x4v=__attribute__((ext_vector_type(4)))float;
constexpr int BATCH=16,NHEAD=16,SEQ=2048,D=64,DM=NHEAD*D;
constexpr int NW=8,QBLK=32,QB=QBLK*NW,KVBLK=64,NQB=SEQ/QB;
constexpr int ATTN_PITCH=DM, ATTN_UNIT_ROWS=QB;
__device__ __forceinline__ int crow(int r,int hi){return (r&3)+8*(r>>2)+4*hi;}
#define SBAR() __builtin_amdgcn_sched_barrier(0)
__device__ __forceinline__ void cmask(f32x16&p0,f32x16&p1,int jb,int qrel,int hi){
  const float NEG=-INFINITY; int kb=64*jb+4*hi;
  #pragma unroll
  for(int r=0;r<16;++r){int kv=kb+(r&3)+8*(r>>2); if(kv>qrel)p0[r]=NEG; if(kv+32>qrel)p1[r]=NEG;}
}

constexpr int NSLOT=3, SLOTB=8192;
constexpr int LDS_K=0, LDS_V=NSLOT*SLOTB, LDS_WS=2*NSLOT*SLOTB, LDS_OST=LDS_WS+NW*64*4, LDS_NB=LDS_OST+NW*4096, LDS_BYTES=LDS_NB+(SEQ+64)*4;
constexpr float C2=0.125f*1.4426950408889634f;
__device__ __forceinline__ void glds16s(const void*sbase,unsigned voff,unsigned lds_dst){unsigned keep;
  asm volatile("s_mov_b32 %0, m0\n\ts_mov_b32 m0, %2\n\ts_nop 0\n\tglobal_load_lds_dwordx4 %1, %3\n\ts_mov_b32 m0, %0":"=&s"(keep):"v"(voff),"s"(lds_dst),"s"(sbase):"memory");}
__device__ __forceinline__ void glds16(const void*gsrc,unsigned lds_dst){unsigned keep;
  asm volatile("s_mov_b32 %0, m0\n\ts_mov_b32 m0, %2\n\ts_nop 0\n\tglobal_load_lds_dwordx4 %1, off\n\ts_mov_b32 m0, %0":"=&s"(keep):"v"(gsrc),"s"(lds_dst):"memory");}
__device__ __forceinline__ float max3f(float a,float b,float c){float r;asm("v_max3_f32 %0, %1, %2, %3":"=v"(r):"v"(a),"v"(b),"v"(c));return r;}
__device__ __forceinline__ float max2f(float a,float b){float r;asm("v_max_f32_e32 %0, %1, %2":"=v"(r):"v"(a),"v"(b));return r;}
__device__ __forceinline__ float fadd_s(float a,float b){float r;asm("v_add_f32_e32 %0, %1, %2":"=v"(r):"v"(a),"v"(b));return r;}
__device__ __forceinline__ float fsub_s(float a,float b){float r;asm("v_sub_f32_e32 %0, %1, %2":"=v"(r):"v"(a),"v"(b));return r;}
typedef float f32x2_t __attribute__((ext_vector_type(2))); typedef __bf16 bf16x2_t __attribute__((ext_vector_type(2)));
__device__ __forceinline__ unsigned cvtpk_s(float lo,float hi){f32x2_t v={lo,hi};bf16x2_t b=__builtin_convertvector(v,bf16x2_t);return __builtin_bit_cast(unsigned,b);}
#define WAIT_BAR(N) asm volatile("s_waitcnt vmcnt(" #N ") lgkmcnt(0)\n\ts_barrier":::"memory")

__device__ __forceinline__ void qkt(f32x16&p0,f32x16&p1,const char*Kslot,const bf16x8*qr,int r32,int hi){
  const char*kb=Kslot+hi*1024+r32*16;
  #pragma unroll
  for(int d0=0;d0<4;++d0){
    const bf16x8 b0=*reinterpret_cast<const bf16x8*>(kb+d0*2048);
    const bf16x8 b1=*reinterpret_cast<const bf16x8*>(kb+d0*2048+512);
    p0=__builtin_amdgcn_mfma_f32_32x32x16_bf16(b0,qr[d0],p0,0,0,0);p1=__builtin_amdgcn_mfma_f32_32x32x16_bf16(b1,qr[d0],p1,0,0,0);}
}
typedef __attribute__((address_space(3))) const char* lds_cptr;
typedef short v4i16_t __attribute__((ext_vector_type(4)));
__device__ __forceinline__ void kload8(bf16x8*kf,lds_cptr kp){
  kf[0]=*(const __attribute__((address_space(3))) bf16x8*)(kp);      kf[1]=*(const __attribute__((address_space(3))) bf16x8*)(kp+512);
  kf[2]=*(const __attribute__((address_space(3))) bf16x8*)(kp+2048); kf[3]=*(const __attribute__((address_space(3))) bf16x8*)(kp+2560);
  kf[4]=*(const __attribute__((address_space(3))) bf16x8*)(kp+4096); kf[5]=*(const __attribute__((address_space(3))) bf16x8*)(kp+4608);
  kf[6]=*(const __attribute__((address_space(3))) bf16x8*)(kp+6144); kf[7]=*(const __attribute__((address_space(3))) bf16x8*)(kp+6656);
}
__device__ __forceinline__ void kload2(bf16x8*kf,lds_cptr kp,int j){ kf[2*j]=*(const __attribute__((address_space(3))) bf16x8*)(kp+j*2048); kf[2*j+1]=*(const __attribute__((address_space(3))) bf16x8*)(kp+j*2048+512); }
__device__ __forceinline__ s16x4 vtr(lds_cptr p){ return __builtin_bit_cast(s16x4,__builtin_amdgcn_ds_read_tr16_b64_v4i16((__attribute__((address_space(3))) v4i16_t*)p)); }
__device__ __forceinline__ float rowmax(const f32x16&p0,const f32x16&p1){
  float a=max3f(p0[0],p0[1],p1[0]),b=max3f(p0[2],p0[3],p1[1]);a=max3f(a,p1[2],p1[3]);
  #pragma unroll
  for(int r=4;r<16;r+=4){a=max3f(a,p0[r],p0[r+1]);b=max3f(b,p0[r+2],p0[r+3]);a=max3f(a,p1[r],p1[r+1]);b=max3f(b,p1[r+2],p1[r+3]);}
  const float m=max2f(a,b);
  auto rr=__builtin_amdgcn_permlane32_swap(__float_as_uint(m),__float_as_uint(m),false,false);
  return max2f(__uint_as_float(rr[0]),__uint_as_float(rr[1]));
}
__device__ __forceinline__ void pv(f32x16*o,int vb,bf16x8 pa0,bf16x8 pa1,bf16x8 pa2,bf16x8 pa3){
  #pragma unroll
  for(int d0=0;d0<2;++d0){s16x4 lo[4],hi[4];
    #pragma unroll
    for(int ks=0;ks<4;++ks){
      asm volatile("ds_read_b64_tr_b16 %0,%1 offset:%c2":"=&v"(lo[ks]):"v"(vb),"i"(d0*4096+ks*1024):"memory");
      asm volatile("ds_read_b64_tr_b16 %0,%1 offset:%c2":"=&v"(hi[ks]):"v"(vb),"i"(d0*4096+ks*1024+512):"memory");}
    asm volatile("s_waitcnt lgkmcnt(0)":::"memory");SBAR();
    #define PK(k) (bf16x8){lo[k][0],lo[k][1],lo[k][2],lo[k][3],hi[k][0],hi[k][1],hi[k][2],hi[k][3]}
    o[d0]=__builtin_amdgcn_mfma_f32_32x32x16_bf16(pa0,PK(0),o[d0],0,0,0);
    o[d0]=__builtin_amdgcn_mfma_f32_32x32x16_bf16(pa1,PK(1),o[d0],0,0,0);
    o[d0]=__builtin_amdgcn_mfma_f32_32x32x16_bf16(pa2,PK(2),o[d0],0,0,0);
    o[d0]=__builtin_amdgcn_mfma_f32_32x32x16_bf16(pa3,PK(3),o[d0],0,0,0);
    #undef PK
  }
}

#ifndef ATTN_STORE16
#define ATTN_STORE16(p,v) (*(u32x4*)(p)=(v))
#endif
template<int THRL> __device__ __forceinline__ void attn_unit(int b,int h,int qb,const bf16*Q,const bf16*__restrict__ K,const bf16*__restrict__ V,bf16*O,char*shm,const int tid,const int tstart,const int tbl_off){
  const int lane=tid&63,r32=lane&31,hi=lane>>5; const int wid=__builtin_amdgcn_readfirstlane(tid>>6);
  const long rowbase=(long)b*SEQ; const int q0=qb*QB;
  const bf16*Qw=Q+(rowbase+q0+wid*QBLK)*DM+h*D;
  const bf16*Kh=K+(rowbase+(long)tstart*KVBLK)*DM+h*D,*Vh=V+(rowbase+(long)tstart*KVBLK)*DM+h*D;
  const unsigned lds0=(unsigned)(uintptr_t)shm;
  float*wsf=(float*)(shm+LDS_WS)+wid*64;
  const unsigned koff=(unsigned)(lane*DM+wid*8)*2u;
  const unsigned voffv=(unsigned)((16*(wid&3)+(lane>>2))*DM+(wid>>2)*32+(lane&3)*8)*2u;
  const unsigned kdst=lds0+LDS_K+wid*1024, vdst=lds0+LDS_V+wid*1024;
  #define DMA_K(t,slot) glds16s(Kh+(long)(t)*KVBLK*DM,koff,(unsigned)__builtin_amdgcn_readfirstlane(kdst+(slot)))
  #define DMA_V(t,slot) glds16s(Vh+(long)(t)*KVBLK*DM,voffv,(unsigned)__builtin_amdgcn_readfirstlane(vdst+(slot)))
  const int vb0=(int)(lds0+LDS_V)+((lane>>4)&1)*32+(lane&3)*8+(4*hi+((lane&15)>>2))*64;
  const char*Kbase=shm+LDS_K; bf16x8 kf[8];
  const lds_cptr shm3=(lds_cptr)shm; const lds_cptr kp0=shm3+LDS_K+hi*1024+r32*16; const lds_cptr vp0=shm3+LDS_V+((lane>>4)&1)*32+(lane&3)*8+(4*hi+((lane&15)>>2))*64;
  const int NT=(q0+QB)/KVBLK-tstart;
  typedef __attribute__((address_space(3))) const f32x4v* nb_cptr;
  const nb_cptr nb0=(nb_cptr)(shm3+LDS_NB+tbl_off)+hi+16*tstart;
  #define BLOAD1(X0,t,H) do{ const nb_cptr p_=nb0+16*(t)+8*(H); \
    _Pragma("unroll") for(int j_=0;j_<4;++j_){ const f32x4v a_=p_[2*j_]; \
      X0[4*j_]=a_[0]-mhat;X0[4*j_+1]=a_[1]-mhat;X0[4*j_+2]=a_[2]-mhat;X0[4*j_+3]=a_[3]-mhat; } asm volatile("":"+v"(X0)); }while(0)
  #define BLOAD(X0,X1,t) do{ BLOAD1(X0,t,0); BLOAD1(X1,t,1); }while(0)
  #define BSUB16(X) do{ _Pragma("unroll") for(int r_=0;r_<16;++r_)X[r_]-=mhat; asm volatile("":"+v"(X)); }while(0)
  DMA_K(0,0);DMA_V(0,0);DMA_K(1,SLOTB);
  bf16x8 qr[4];
  #pragma unroll
  for(int d0=0;d0<4;++d0)qr[d0]=*reinterpret_cast<const bf16x8*>(&Qw[(long)r32*DM+d0*16+hi*8]);
  float mhat=0.f,l_reg=0.f;f32x16 o[2];o[0]=f32x16{};o[1]=f32x16{};
  const int qrel=wid*QBLK+r32;
  #define CMASK(P0,P1,t) do{int jb_=(t)-(NT-4); if(jb_>=0)cmask(P0,P1,jb_,qrel,hi);}while(0)
  bool resc=false;
  #define START(P0,P1) do{ const float rm=rowmax(P0,P1); resc=false; \
    { const float dl=rm; mhat=fadd_s(mhat,dl); \
      _Pragma("unroll") for(int r=0;r<16;++r){P0[r]=fsub_s(P0[r],dl);P1[r]=fsub_s(P1[r],dl);} } \
    _Pragma("unroll") for(int r=0;r<16;++r)P0[r]=__builtin_amdgcn_exp2f(P0[r]); }while(0)
  #define RESC() do{ if(resc){ asm volatile("s_waitcnt lgkmcnt(0)":::"memory"); \
      _Pragma("unroll") for(int d_=0;d_<2;++d_) _Pragma("unroll") for(int r=0;r<16;++r)o[d_][r]*=wsf[crow(r,hi)]; } }while(0)
  f32x16 pA0,pA1,pB0,pB1;
  int sl_prev=0,sl_cur=0,sl_next=SLOTB;
  #define ROT() do{sl_prev=sl_cur;sl_cur=sl_next;sl_next=(sl_next==(NSLOT-1)*SLOTB)?0:sl_next+SLOTB;}while(0)
  DMA_K(2,2*SLOTB);
  WAIT_BAR(3);
  BLOAD(pA0,pA1,0); qkt(pA0,pA1,Kbase,qr,r32,hi);asm volatile("s_nop 15\n\ts_nop 7":"+v"(pA0),"+v"(pA1));CMASK(pA0,pA1,0);
  START(pA0,pA1);
  _Pragma("unroll") for(int r=0;r<16;++r)pA1[r]=__builtin_amdgcn_exp2f(pA1[r]);
  WAIT_BAR(0);
  DMA_K(3,0);DMA_V(1,SLOTB);
  ROT();
  kload8(kf,kp0+sl_cur);
  WAIT_BAR(2);
  s16x4 vlo[8],vhi[8]; u32x4 pw0,pw1,pw2,pw3;
  #define PKW(P,B) cvtpk_s(P[B],P[B+1])
  #define PAF(k) __builtin_bit_cast(bf16x8,pw##k)
  #define VFR(i) (bf16x8){vlo[i][0],vlo[i][1],vlo[i][2],vlo[i][3],vhi[i][0],vhi[i][1],vhi[i][2],vhi[i][3]}
  #define PIN(x) asm volatile("":"+v"(x))
  #define MX3(a,b,c) __builtin_fmaxf(__builtin_fmaxf((a),(b)),(c))
  #define GAPA(MF,A0,A1,A2,A3,W0,W1,PW) do{ MF; sacc+=A0; sacc+=A1; sacc+=A2; sacc+=A3; PIN(sacc); W0; W1; PIN(PW); SBAR(); }while(0)
  #define EX(v) __builtin_amdgcn_exp2f(v)
  #define GAPB(MF,X,B) do{ MF; X[B]=EX(X[B]); X[B+1]=EX(X[B+1]); X[B+2]=EX(X[B+2]); X[B+3]=EX(X[B+3]); PIN(X); SBAR(); }while(0)
  #define VRD(i) do{ vlo[i]=vtr(vp_+(((i)>>2)*4096+((i)&3)*1024)); vhi[i]=vtr(vp_+(((i)>>2)*4096+((i)&3)*1024+512)); }while(0)
  #define KRD(G,j) do{ if(G){ kload2(kf,kp0+sl_next,j); SBAR(); } }while(0)
  #define STEP(C0,C1,P0,P1,t,GK,GV,GL) do{ SBAR(); \
    const lds_cptr vp_=vp0+sl_prev; \
    BLOAD1(C0,t,0); VRD(0); SBAR(); float sacc=(P0[0]+P0[1]); \
    GAPA(C0=__builtin_amdgcn_mfma_f32_32x32x16_bf16(kf[0],qr[0],C0,0,0,0), P0[2],P0[3],P0[4],P0[5],     pw0[0]=PKW(P0,0), pw0[1]=PKW(P0,2), pw0); \
    BLOAD1(C1,t,1); VRD(4); SBAR(); GAPA(C1=__builtin_amdgcn_mfma_f32_32x32x16_bf16(kf[1],qr[0],C1,0,0,0), P0[6],P0[7],P0[8],P0[9],     pw0[2]=PKW(P0,4), pw0[3]=PKW(P0,6), pw0); \
    VRD(1); SBAR(); GAPA(C0=__builtin_amdgcn_mfma_f32_32x32x16_bf16(kf[2],qr[1],C0,0,0,0),   P0[10],P0[11],P0[12],P0[13], pw1[0]=PKW(P0,8), pw1[1]=PKW(P0,10), pw1); \
    VRD(5); SBAR(); GAPA(C1=__builtin_amdgcn_mfma_f32_32x32x16_bf16(kf[3],qr[1],C1,0,0,0),   P0[14],P0[15],P1[0],P1[1],   pw1[2]=PKW(P0,12),pw1[3]=PKW(P0,14), pw1); \
    VRD(2); SBAR(); GAPA(C0=__builtin_amdgcn_mfma_f32_32x32x16_bf16(kf[4],qr[2],C0,0,0,0),   P1[2],P1[3],P1[4],P1[5],     pw2[0]=PKW(P1,0), pw2[1]=PKW(P1,2), pw2); \
    VRD(6); SBAR(); GAPA(C1=__builtin_amdgcn_mfma_f32_32x32x16_bf16(kf[5],qr[2],C1,0,0,0),   P1[6],P1[7],P1[8],P1[9],     pw2[2]=PKW(P1,4), pw2[3]=PKW(P1,6), pw2); \
    VRD(3); SBAR(); GAPA(C0=__builtin_amdgcn_mfma_f32_32x32x16_bf16(kf[6],qr[3],C0,0,0,0),   P1[10],P1[11],P1[12],P1[13], pw3[0]=PKW(P1,8), pw3[1]=PKW(P1,10), pw3); \
    VRD(7); SBAR(); GAPA(C1=__builtin_amdgcn_mfma_f32_32x32x16_bf16(kf[7],qr[3],C1,0,0,0),   P1[14],P1[15],0.f,0.f,       pw3[2]=PKW(P1,12),pw3[3]=PKW(P1,14), pw3); \
    l_reg+=sacc; \
    if(GK){DMA_K((t)+3,sl_cur);} if(GV){DMA_V((t)+1,sl_next);} \
    CMASK(C0,C1,t); \
    { float a=MX3(C0[0],C0[1],C1[0]),b=MX3(C0[2],C0[3],C1[1]); a=MX3(a,C1[2],C1[3]); \
      _Pragma("unroll") for(int r=4;r<16;r+=4){a=MX3(a,C0[r],C0[r+1]);b=MX3(b,C0[r+2],C0[r+3]);a=MX3(a,C1[r],C1[r+1]);b=MX3(b,C1[r+2],C1[r+3]);} \
      float rm=__builtin_fmaxf(a,b); { auto rr=__builtin_amdgcn_permlane32_swap(__float_as_uint(rm),__float_as_uint(rm),false,false); rm=__builtin_fmaxf(__uint_as_float(rr[0]),__uint_as_float(rr[1])); } \
      resc=false; \
      if(__builtin_expect(__any(rm>(float)THRL),0)){ const float dl=__builtin_fmaxf(rm,0.f); mhat+=dl; \
        _Pragma("unroll") for(int r=0;r<16;++r){C0[r]-=dl;C1[r]-=dl;} \
        const float f=__builtin_amdgcn_exp2f(-dl); l_reg*=f; if(hi==0)wsf[r32]=f; resc=true; } } \
    SBAR(); \
    GAPB(o[0]=__builtin_amdgcn_mfma_f32_32x32x16_bf16(PAF(0),VFR(0),o[0],0,0,0), C0,0); \
    GAPB(o[1]=__builtin_amdgcn_mfma_f32_32x32x16_bf16(PAF(0),VFR(4),o[1],0,0,0), C0,4); \
    KRD(GL,0); GAPB(o[0]=__builtin_amdgcn_mfma_f32_32x32x16_bf16(PAF(1),VFR(1),o[0],0,0,0), C0,8); \
    KRD(GL,1); GAPB(o[1]=__builtin_amdgcn_mfma_f32_32x32x16_bf16(PAF(1),VFR(5),o[1],0,0,0), C0,12); \
    KRD(GL,2); GAPB(o[0]=__builtin_amdgcn_mfma_f32_32x32x16_bf16(PAF(2),VFR(2),o[0],0,0,0), C1,0); \
    KRD(GL,3); GAPB(o[1]=__builtin_amdgcn_mfma_f32_32x32x16_bf16(PAF(2),VFR(6),o[1],0,0,0), C1,4); \
    GAPB(o[0]=__builtin_amdgcn_mfma_f32_32x32x16_bf16(PAF(3),VFR(3),o[0],0,0,0), C1,8); \
    GAPB(o[1]=__builtin_amdgcn_mfma_f32_32x32x16_bf16(PAF(3),VFR(7),o[1],0,0,0), C1,12); \
    }while(0)
  int t=1;
  #undef CMASK
  #define CMASK(P0,P1,t) do{}while(0)
  for(;t+5<NT;t+=2){
    STEP(pB0,pB1,pA0,pA1,t,true,true,true);     WAIT_BAR(2); RESC(); ROT();
    STEP(pA0,pA1,pB0,pB1,t+1,true,true,true);   WAIT_BAR(2); RESC(); ROT();
  }
  #undef CMASK
  #define CMASK(P0,P1,t) do{int jb_=(t)-(NT-4); if(jb_>=0)cmask(P0,P1,jb_,qrel,hi);}while(0)
  #define ENDW(tt) do{ if((tt)+3<NT){WAIT_BAR(2);} else if((tt)+2<NT){WAIT_BAR(1);} else {WAIT_BAR(0);} }while(0)
  for(;t+1<NT;t+=2){
    STEP(pB0,pB1,pA0,pA1,t,(t+3<NT),(t+1<NT),(t+1<NT));       ENDW(t);   RESC(); ROT();
    STEP(pA0,pA1,pB0,pB1,t+1,(t+4<NT),(t+2<NT),(t+2<NT));     ENDW(t+1); RESC(); ROT();
  }
  STEP(pB0,pB1,pA0,pA1,NT-1,false,false,false); RESC();
  { float sacc=pB0[0]+pB0[1]; _Pragma("unroll") for(int r=2;r<16;++r)sacc+=pB0[r]; _Pragma("unroll") for(int r=0;r<16;++r)sacc+=pB1[r]; l_reg+=sacc;
    pw0=(u32x4){PKW(pB0,0),PKW(pB0,2),PKW(pB0,4),PKW(pB0,6)};pw1=(u32x4){PKW(pB0,8),PKW(pB0,10),PKW(pB0,12),PKW(pB0,14)};pw2=(u32x4){PKW(pB1,0),PKW(pB1,2),PKW(pB1,4),PKW(pB1,6)};pw3=(u32x4){PKW(pB1,8),PKW(pB1,10),PKW(pB1,12),PKW(pB1,14)};
    SBAR(); pv(o,vb0+sl_cur,PAF(0),PAF(1),PAF(2),PAF(3)); }
  #undef PKW
  #undef PAF
  #undef VFR
  #undef PIN
  #undef MX3
  #undef GAPA
  #undef GAPB
  #undef EX
  #undef VRD
  #undef KRD
  #undef STEP
  #undef ENDW
  {auto rr=__builtin_amdgcn_permlane32_swap(__float_as_uint(l_reg),__float_as_uint(l_reg),false,false);l_reg=__uint_as_float(rr[0])+__uint_as_float(rr[1]);}
  if(hi==0)wsf[32+r32]=l_reg;asm volatile("s_waitcnt lgkmcnt(0)":::"memory");
  float rli[16];
  #pragma unroll
  for(int r=0;r<16;++r)rli[r]=__builtin_amdgcn_rcpf(wsf[32+crow(r,hi)]);
  bf16*Ow=O+(rowbase+q0+wid*QBLK)*DM+h*D;
  { bf16*stg=(bf16*)(shm+LDS_OST)+wid*2048;
    #pragma unroll
    for(int r=0;r<16;++r){const int orow=crow(r,hi);
      #pragma unroll
      for(int d0=0;d0<2;++d0)stg[orow*64+d0*32+r32]=__float2bfloat16(o[d0][r]*rli[r]);}
    asm volatile("s_waitcnt lgkmcnt(0)":::"memory");
    #pragma unroll
    for(int i=0;i<4;++i){const int row=i*8+(lane>>3),ch=lane&7; const u32x4 v=*(const u32x4*)(stg+row*64+ch*8); ATTN_STORE16(Ow+(long)row*DM+ch*8,v);} }
  asm volatile("s_waitcnt lgkmcnt(0)\n\ts_barrier":::"memory");
  #undef BLOAD
  #undef BLOAD1
  #undef BSUB16
  #undef DMA_K
  #undef DMA_V
  #undef CMASK
  #undef START
  #undef RESC
  #undef ROT
}
constexpr int ATTN_LDS_BYTES=LDS_BYTES;
#undef SBAR
#undef WAIT_BAR
}

#define LAS __attribute__((address_space(3)))
typedef unsigned short bfu;
typedef float f32x4 __attribute__((ext_vector_type(4)));
typedef unsigned v4u __attribute__((ext_vector_type(4)));
typedef unsigned v2u __attribute__((ext_vector_type(2)));
typedef short bf16x8 __attribute__((ext_vector_type(8)));
constexpr int NB = 16, SEQ = 2048, DM = 1024, MTOK = NB * SEQ, FF = 2816, NLAYER = 2, DIN = 7184, NZ = 21 * 256;
constexpr size_t MiB = 1u << 20;
constexpr size_t WO_UP1 = 0, WO_DN1 = WO_UP1 + (size_t)5632 * 1024, WO_IN = WO_DN1 + (size_t)1024 * 2816, WO_GATE = WO_IN + (size_t)NZ * 1024, WO_LRU = WO_GATE + (size_t)2048 * 1024,
                 WO_ATT = WO_LRU + (size_t)1024 * 1024, WO_O = WO_ATT + (size_t)1024 * 1024, WO_UP2 = WO_O + (size_t)1024 * 1024, WO_DN2 = WO_UP2 + (size_t)5632 * 1024, WL_ELEMS = WO_DN2 + (size_t)1024 * 2816;
constexpr size_t WS_RSQ = 0, WS_W = 4 * MiB, WS_XB = 112 * MiB, WS_LOGF = 176 * MiB, WS_ZLX = 178 * MiB, WS_G = 242 * MiB, WS_Q = 306 * MiB, WS_K = 370 * MiB, WS_V = 434 * MiB, WS_END = 498 * MiB;
constexpr size_t WS_ACT = WS_ZLX; constexpr size_t WS_RSTD2 = 111 * MiB + 512 * 1024, WS_BAR = 111 * MiB + 768 * 1024, BAR_BYTES = 16384;
static_assert(WS_W + 2 * WL_ELEMS * 2 <= WS_RSTD2 && WS_RSTD2 + MTOK * 4 <= WS_XB && MTOK == pg8::RSQ_ROWS && WS_W + 2 * WL_ELEMS * 2 <= WS_XB && (size_t)MTOK * FF * 2 <= WS_K - WS_ZLX, "workspace map");
constexpr int LDS_BYTES = 147456;

__device__ __forceinline__ unsigned f2bf(float f) { unsigned u = __builtin_bit_cast(unsigned, f); return (u + 0x7fffu + ((u >> 16) & 1u)) >> 16; }
__device__ __forceinline__ unsigned pk2(float lo, float hi) { return f2bf(lo) | (f2bf(hi) << 16); }
__device__ __forceinline__ float bf2f(unsigned short h) { return __uint_as_float((unsigned)h << 16); }
#define LDS_WAIT() asm volatile("s_waitcnt lgkmcnt(0)" ::: "memory")

__device__ __forceinline__ void tr_item64(const float* W, int N, int K, int k0, int srcA, int nvA, int srcB, int nvB, const float* g, bfu* WT, int dst_row0, LAS float* scr, int lane) {
    const int h = (lane >> 3) & 1, c4 = 4 * (lane & 7); const bool ok = c4 < (h ? nvB : nvA);
    const float* wp = W + (size_t)(k0 + (lane >> 4)) * N + (h ? srcB : srcA) + c4; const float* gp = g ? g + k0 + (lane >> 4) : nullptr;
    LAS float* sp = scr + (lane >> 4) * 65 + 32 * h + c4;
#pragma unroll 8
    for (int i = 0; i < 16; ++i) { f32x4 v = {0.f, 0.f, 0.f, 0.f}; if (ok) v = *(const f32x4*)(wp + (size_t)(4 * i) * N); if (gp) v = v * gp[4 * i];
        sp[(4 * i) * 65 + 0] = v[0]; sp[(4 * i) * 65 + 1] = v[1]; sp[(4 * i) * 65 + 2] = v[2]; sp[(4 * i) * 65 + 3] = v[3]; }
    LDS_WAIT(); asm volatile("" ::: "memory");
    const int c = lane & 7;
#pragma unroll
    for (int q = 0; q < 8; ++q) { const int n = 8 * q + (lane >> 3); const LAS float* s = scr + (8 * c) * 65 + n;
        v4u o; o.x = pk2(s[0 * 65], s[1 * 65]); o.y = pk2(s[2 * 65], s[3 * 65]); o.z = pk2(s[4 * 65], s[5 * 65]); o.w = pk2(s[6 * 65], s[7 * 65]);
        *(v4u*)(WT + (size_t)(dst_row0 + n) * K + k0 + 8 * c) = o; }
    LDS_WAIT(); asm volatile("" ::: "memory");
}
__device__ __forceinline__ void win_src(int r, int& src, int& nv) { const int pn = r >> 3, r8 = r & 7; nv = 32;
    if (pn < 8) src = 256 * pn + 32 * r8;
    else if (pn < 16) src = 2048 + 256 * (pn - 8) + 64 * (r8 & 3) + 32 * (r8 >> 2);
    else if (pn < 20) src = 4096 + 256 * (pn - 16) + 32 * r8;
    else { src = 5120; nv = (r8 == 0) ? 16 : 0; } }
__device__ __forceinline__ int up_src(int r) { const int pn = r >> 3, r8 = r & 7; return (r8 >> 2) * 2816 + 128 * pn + 32 * (r8 & 3); }
struct Args { const float* in[23]; float* out; unsigned char* ws; };

typedef const __attribute__((address_space(4))) Args* kargs_t;
__device__ __forceinline__ void prologue(kargs_t a, LAS unsigned char* lds, int gw, int NGW, int wave, int lane) {
    LAS float* scr = (LAS float*)(lds + wave * 16640);
    constexpr int I_UP = 88 * 16, I_DN = 16 * 44, I_IN = 84 * 16, I_GT = 32 * 16, I_SQ = 16 * 16;
    constexpr int I_LAYER = 2 * I_UP + 2 * I_DN + I_IN + I_GT + 3 * I_SQ;
    for (int it = gw; it < NLAYER * I_LAYER; it += NGW) {
        const int l = it / I_LAYER; int r = it - l * I_LAYER;
        bfu* WL = (bfu*)(a->ws + WS_W) + (size_t)l * WL_ELEMS;
        if (r < 2 * I_UP) { const int second = r >= I_UP; if (second) r -= I_UP;
            const int kb = r / 88, nb = r - kb * 88;
            tr_item64(a->in[second ? 21 : 2] + (size_t)l * 1024 * 5632, 5632, 1024, kb * 64, up_src(2 * nb), 32, up_src(2 * nb + 1), 32, a->in[second ? 20 : 1] + l * 1024, WL + (second ? WO_UP2 : WO_UP1), nb * 64, scr, lane); continue; }
        r -= 2 * I_UP;
        if (r < 2 * I_DN) { const int second = r >= I_DN; if (second) r -= I_DN;
            const int kb = r >> 4, nb = r & 15;
            tr_item64(a->in[second ? 22 : 3] + (size_t)l * 2816 * 1024, 1024, 2816, kb * 64, nb * 64, 32, nb * 64 + 32, 32, nullptr, WL + (second ? WO_DN2 : WO_DN1), nb * 64, scr, lane); continue; }
        r -= 2 * I_DN;
        if (r < I_IN) { const int kb = r / 84, nb = r - kb * 84; int sA, nA, sB, nB; win_src(2 * nb, sA, nA); win_src(2 * nb + 1, sB, nB);
            tr_item64(a->in[5] + (size_t)l * 1024 * DIN, DIN, 1024, kb * 64, sA, nA, sB, nB, a->in[4] + l * 1024, WL + WO_IN, nb * 64, scr, lane); continue; }
        r -= I_IN;
        if (r < I_GT) { const int kb = r >> 5, nb = r & 31;
            tr_item64(a->in[5] + (size_t)l * 1024 * DIN, DIN, 1024, kb * 64, 5136 + 64 * nb, 32, 5136 + 64 * nb + 32, 32, a->in[4] + l * 1024, WL + WO_GATE, nb * 64, scr, lane); continue; }
        r -= I_GT;
        { const int w = r / I_SQ; r -= w * I_SQ; const int kb = r >> 4, nb = r & 15;
            tr_item64(a->in[17 + w] + (size_t)l * 1024 * 1024, 1024, 1024, kb * 64, nb * 64, 32, nb * 64 + 32, 32, nullptr, WL + (w == 0 ? WO_LRU : w == 1 ? WO_ATT : WO_O), nb * 64, scr, lane); }
    }
    float* rsq = (float*)(a->ws + WS_RSQ); bfu* xb = (bfu*)(a->ws + WS_XB);
    for (int m0 = 2 * gw; m0 < MTOK; m0 += 2 * NGW) {
        f32x4 v[2][4]; float sq[2];
#pragma unroll
        for (int rr = 0; rr < 2; ++rr) { const f32x4* xr = (const f32x4*)(a->in[0] + (size_t)(m0 + rr) * DM) + lane;
#pragma unroll
            for (int j = 0; j < 4; ++j) v[rr][j] = xr[64 * j]; }
#pragma unroll
        for (int rr = 0; rr < 2; ++rr) { float s = 0.f;
#pragma unroll
            for (int j = 0; j < 4; ++j) s += (v[rr][j][0] * v[rr][j][0] + v[rr][j][1] * v[rr][j][1]) + (v[rr][j][2] * v[rr][j][2] + v[rr][j][3] * v[rr][j][3]);
#pragma unroll
            for (int o = 1; o < 64; o <<= 1) s += pg8::bperm(lane ^ o, s);
            sq[rr] = s; }
#pragma unroll
        for (int rr = 0; rr < 2; ++rr) { const int m = m0 + rr;
            if (lane < 16) rsq[(size_t)m * 16 + lane] = lane == 0 ? sq[rr] : 0.f;
            v2u* o8 = (v2u*)(xb + (size_t)m * DM) + lane;
#pragma unroll
            for (int j = 0; j < 4; ++j) { v2u w; w.x = pk2(v[rr][j][0], v[rr][j][1]); w.y = pk2(v[rr][j][2], v[rr][j][3]); o8[64 * j] = w; } } }
}

constexpr int SC_XA = 0, SC_WT = 17408, SC_XF = 52224, SC_AA = 68608, SC_UU = 84992, SC_SEG = 101376, SC_CAR = 105472, SC_CW = 105984, SC_CH = 108544, SC_GT = 109312, SC_YT = 118528, SC_END = 127744;
__device__ __forceinline__ void scan_item(LAS unsigned char* lds, int b, int n, int hf, const bfu* ZLX, bfu* G, const float* conv_w, const float* conv_b,
                                          const float* w_a, const float* b_a, const float* w_x, const float* b_x, const float* lam, int tid) {
    LAS bfu* XA = (LAS bfu*)(lds + SC_XA); LAS bfu* WT = (LAS bfu*)(lds + SC_WT); LAS float* XF = (LAS float*)(lds + SC_XF); LAS float* AA = (LAS float*)(lds + SC_AA); LAS float* UU = (LAS float*)(lds + SC_UU);
    LAS float* SEG = (LAS float*)(lds + SC_SEG); LAS float* CAR = (LAS float*)(lds + SC_CAR); LAS float* CW = (LAS float*)(lds + SC_CW); LAS float* CH = (LAS float*)(lds + SC_CH);
    LAS bfu* GT = (LAS bfu*)(lds + SC_GT); LAS bfu* YT = (LAS bfu*)(lds + SC_YT);
    const int lane = tid & 63, wave = tid >> 6;
    for (int idx = tid; idx < 128 * 64; idx += 512) { const int c = idx >> 6, dl = idx & 63; const size_t src = ((size_t)n * 128 + c) * 128 + 64 * hf + dl;
        const unsigned pw_ = pg8::cvt_pk_bf16(w_a[src], w_x[src]); WT[dl * 136 + c] = (bfu)(pw_ & 0xffffu); WT[(64 + dl) * 136 + c] = (bfu)(pw_ >> 16); }
    if (tid < 128) { CW[tid] = conv_w[128 * n + tid]; CW[128 + tid] = conv_w[1024 + 128 * n + tid]; CW[256 + tid] = conv_w[2048 + 128 * n + tid]; CW[384 + tid] = conv_w[3072 + 128 * n + tid]; CW[512 + tid] = conv_b[128 * n + tid]; }
    if (tid < 64) { const int d = 128 * n + 64 * hf + tid; CH[tid] = b_a[d]; CH[64 + tid] = b_x[d]; CH[128 + tid] = 8.0f * log1pf(expf(-lam[d])); CAR[tid] = 0.f; }
    __syncthreads();
    const int cg4 = tid & 31, tg = tid >> 5;
    f32x4 cw[4], cb;
#pragma unroll
    for (int k = 0; k < 4; ++k) cw[k] = *(const LAS f32x4*)(CW + 128 * k + 4 * cg4);
    cb = *(const LAS f32x4*)(CW + 512 + 4 * cg4);
    const int tt = wave >> 1, cts = 2 * (wave & 1), l15 = lane & 15, lq = lane >> 4;
    const int sc = tid & 63, sg = tid >> 6;
    bf16x8 wfr[2][2][4];
#pragma unroll
    for (int mt = 0; mt < 2; ++mt)
#pragma unroll
        for (int ci = 0; ci < 2; ++ci)
#pragma unroll
            for (int ks = 0; ks < 4; ++ks) wfr[mt][ci][ks] = *(const LAS bf16x8*)(WT + (64 * mt + 16 * (cts + ci) + l15) * 136 + 32 * ks + 8 * lq);
    const size_t rowb = (size_t)b * SEQ;
    const bfu* zsrc = ZLX + rowb * DM + 128 * n + 4 * cg4;
    v2u xw[7];
#pragma unroll
    for (int i = 0; i < 7; ++i) { const int r = 4 * tg - 3 + i; xw[i] = (v2u){0u, 0u}; if (r >= 0) xw[i] = *(const v2u*)(zsrc + (size_t)r * DM); }
    for (int ch = 0; ch < SEQ / 64; ++ch) {
        const int t0 = ch * 64;
        bfu* gio = G + (rowb + t0 + (tid >> 3)) * DM + 128 * n + 64 * hf + 8 * (tid & 7);
        const v4u gvec = *(const v4u*)gio;
        { f32x4 xr[7];
#pragma unroll
            for (int i = 0; i < 7; ++i) { const v2u w = xw[i];
                xr[i][0] = __uint_as_float(w.x << 16); xr[i][1] = __uint_as_float(w.x & 0xffff0000u); xr[i][2] = __uint_as_float(w.y << 16); xr[i][3] = __uint_as_float(w.y & 0xffff0000u); }
            if (ch + 1 < SEQ / 64) {
#pragma unroll
                for (int i = 0; i < 7; ++i) xw[i] = *(const v2u*)(zsrc + (size_t)(t0 + 64 + 4 * tg - 3 + i) * DM); }
#pragma unroll
            for (int j = 0; j < 4; ++j) { f32x4 y = cb + cw[0] * xr[j] + cw[1] * xr[j + 1] + cw[2] * xr[j + 2] + cw[3] * xr[j + 3];
                v2u w; w.x = pg8::cvt_pk_bf16(y[0], y[1]); w.y = pg8::cvt_pk_bf16(y[2], y[3]); *(LAS v2u*)(XA + (4 * tg + j) * 136 + 4 * cg4) = w;
                if ((cg4 >> 4) == hf) *(LAS f32x4*)(XF + (4 * tg + j) * 64 + 4 * (cg4 & 15)) = y; } }
        __syncthreads();
        *(LAS v4u*)(GT + (tid >> 3) * 64 + 8 * (tid & 7)) = gvec;
        if (ch > 0) *(v4u*)(gio - (size_t)64 * DM) = *(const LAS v4u*)(YT + (tid >> 3) * 64 + 8 * (tid & 7));
        { f32x4 acc[2][2];
#pragma unroll
            for (int mt = 0; mt < 2; ++mt)
#pragma unroll
                for (int ci = 0; ci < 2; ++ci) acc[mt][ci] = (f32x4){0.f, 0.f, 0.f, 0.f};
#pragma unroll
            for (int ks = 0; ks < 4; ++ks) { const bf16x8 af = *(const LAS bf16x8*)(XA + (16 * tt + l15) * 136 + 32 * ks + 8 * lq);
#pragma unroll
                for (int mt = 0; mt < 2; ++mt)
#pragma unroll
                    for (int ci = 0; ci < 2; ++ci) acc[mt][ci] = __builtin_amdgcn_mfma_f32_16x16x32_bf16(af, wfr[mt][ci][ks], acc[mt][ci], 0, 0, 0); }
#pragma unroll
            for (int ci = 0; ci < 2; ++ci) { const int d = 16 * (cts + ci) + l15; const float ba = CH[d], bx = CH[64 + d], sp8 = CH[128 + d];
#pragma unroll
                for (int j = 0; j < 4; ++j) { const int tok = 16 * tt + 4 * lq + j;
                    const float r = pg8::sigm(acc[0][ci][j] + ba), ig = pg8::sigm(acc[1][ci][j] + bx);
                    const float la = -sp8 * r, av = __builtin_amdgcn_exp2f(pg8::kLog2e * la);
                    const float om = __builtin_fmaf(-av, av, 1.0f);
                    AA[tok * 64 + d] = av; UU[tok * 64 + d] = __builtin_sqrtf(om) * ig * XF[tok * 64 + d]; } } }
        __syncthreads();
        { float av[8], uv[8];
#pragma unroll
            for (int k = 0; k < 8; ++k) { av[k] = AA[(8 * sg + k) * 64 + sc]; uv[k] = UU[(8 * sg + k) * 64 + sc]; }
            float P = 1.f, H = 0.f;
#pragma unroll
            for (int k = 0; k < 8; ++k) { H = av[k] * H + uv[k]; P *= av[k]; }
            SEG[(sg * 64 + sc) * 2] = P; SEG[(sg * 64 + sc) * 2 + 1] = H;
            __syncthreads();
            float h = CAR[(ch & 1) * 64 + sc];
            { float sp_[7], sh_[7];
#pragma unroll
              for (int s = 0; s < 7; ++s) { sp_[s] = SEG[(s * 64 + sc) * 2]; sh_[s] = SEG[(s * 64 + sc) * 2 + 1]; }
#pragma unroll
              for (int s = 0; s < 7; ++s) h = (s < sg) ? sp_[s] * h + sh_[s] : h; }
#pragma unroll
            for (int k = 0; k < 8; ++k) { h = av[k] * h + uv[k]; YT[(8 * sg + k) * 64 + sc] = (bfu)(pg8::cvt_pk_bf16(bf2f(GT[(8 * sg + k) * 64 + sc]) * h, 0.f) & 0xffffu); }
            if (sg == 7) CAR[((ch + 1) & 1) * 64 + sc] = h; }
    }
    __syncthreads();
    *(v4u*)(G + (rowb + SEQ - 64 + (tid >> 3)) * DM + 128 * n + 64 * hf + 8 * (tid & 7)) = *(const LAS v4u*)(YT + (tid >> 3) * 64 + 8 * (tid & 7));
    __syncthreads();
}

__device__ __forceinline__ void forget_phase(const bfu* xb, const bfu* wf  , const float* rowsq, const float* bforget, float* logf, float* rstd2, int bx, int G, int tid) {
    const int lane = tid & 63, wave = tid >> 6, l15 = lane & 15, lq = lane >> 4;
    for (int blk = bx * 8 + wave; blk < MTOK / 16; blk += G * 8) {
        const int row0 = blk * 16;
        const bfu* ap = xb + (size_t)(row0 + l15) * DM + 8 * lq; const bfu* bp = wf + (size_t)l15 * DM + 8 * lq;
        f32x4 acc = {0.f, 0.f, 0.f, 0.f};
#pragma unroll 8
        for (int ks = 0; ks < 32; ++ks) { const bf16x8 af = *(const bf16x8*)(ap + 32 * ks), bfv = *(const bf16x8*)(bp + 32 * ks); acc = __builtin_amdgcn_mfma_f32_16x16x32_bf16(af, bfv, acc, 0, 0, 0); }
        const float bf = bforget[l15];
#pragma unroll
        for (int j = 0; j < 4; ++j) { const int row = row0 + 4 * lq + j; const f32x4* pp = (const f32x4*)(rowsq + (size_t)row * 16);
            const f32x4 p0 = pp[0], p1 = pp[1], p2 = pp[2], p3 = pp[3];
            const float ssum = ((p0[0] + p0[1]) + (p0[2] + p0[3])) + ((p1[0] + p1[1]) + (p1[2] + p1[3])) + ((p2[0] + p2[1]) + (p2[2] + p2[3])) + ((p3[0] + p3[1]) + (p3[2] + p3[3]));
            const float rs = __builtin_amdgcn_rsqf(ssum * (1.0f / 1024.0f) + 1e-6f);
            const float x = acc[j] * rs + bf;
            logf[(size_t)row * 16 + l15] = fminf(x, 0.f) - log1pf(__expf(-fabsf(x)));
            if (l15 == 0) rstd2[row] = rs; }
    }
}
constexpr int ATT_TBL_BYTES = (SEQ + 64) * 4, ATT_SCR_OFF = attn_body::LDS_NB + 4 * ATT_TBL_BYTES;
__device__ __forceinline__ void bias_table(LAS unsigned char* lds, const float* logf, const float* gq, const float* gk, int b, int h, int tid, int tbl) {
    LAS float* nb = (LAS float*)(lds + attn_body::LDS_NB + tbl * ATT_TBL_BYTES); LAS float* wsum = (LAS float*)(lds + ATT_SCR_OFF);
    const int lane = tid & 63, wave = tid >> 6;
    const float* p = logf + ((size_t)b * SEQ + 4 * tid) * 16 + h;
    float v0 = p[0], v1 = p[16], v2 = p[32], v3 = p[48];
    v1 += v0; v2 += v1; v3 += v2;
    float s = v3;
#pragma unroll
    for (int o = 1; o < 64; o <<= 1) { const float t = pg8::bperm(lane - o, s); if (lane >= o) s += t; }
    if (lane == 63) wsum[wave] = s;
    __syncthreads();
    float off = s - v3;
    for (int w = 0; w < wave; ++w) off += wsum[w];
    const float k = -pg8::kLog2e;
    *(LAS f32x4*)(nb + 4 * tid) = (f32x4){(off + v0) * k, (off + v1) * k, (off + v2) * k, (off + v3) * k};
    if (tid < 64) { nb[SEQ + tid] = 0.f;
        float mq = fabsf(gq[tid]), mk = fabsf(gk[tid]);
#pragma unroll
        for (int o = 1; o < 64; o <<= 1) { mq = fmaxf(mq, pg8::bperm(lane ^ o, mq)); mk = fmaxf(mk, pg8::bperm(lane ^ o, mk)); }
        if (tid == 0) wsum[8] = attn_body::C2 * 64.0f * mq * mk; }
    __syncthreads();
}

#define GRID_SYNC_CG() do { asm volatile("s_waitcnt vmcnt(0) lgkmcnt(0)" ::: "memory"); grid.sync(); } while (0)
#define GRID_SYNC() do { kargs_t apb_ = (kargs_t)__builtin_amdgcn_kernarg_segment_ptr(); asm volatile("" : "+s"(apb_)); XcdBarrier xb_; xb_.bar = (unsigned*)(apb_->ws + WS_BAR); xb_.x = xb_xcc_id(); xb_.st = (volatile LAS unsigned*)(lds + (LDS_BYTES - 64)); \
    TID_NOW(tb_); xcd_barrier(xb_, tb_ == 0); } while (0)
#define PHASE_ARGS() kargs_t ap = (kargs_t)__builtin_amdgcn_kernarg_segment_ptr(); asm volatile("" : "+s"(ap)); unsigned char* const ws = ap->ws; (void)ws

#define RLX_AGENT __ATOMIC_RELAXED, __HIP_MEMORY_SCOPE_AGENT
#define XB_TMO      128
#define XB_XCNT(j)  (256  + 64 * (j))
#define XB_XSUB(j)  (1280 + 64 * (j))
#define XB_XGEN(j)  (2304 + 64 * (j))
#define XB_TOP      3328
#define XB_TOPGEN   3392
#define XCD_BAR_WORDS 3456
#define XB_SPIN_CAP (1u << 18)

__device__ __forceinline__ unsigned xb_ld(unsigned* p)              { return __hip_atomic_load(p, __ATOMIC_RELAXED, __HIP_MEMORY_SCOPE_AGENT); }
__device__ __forceinline__ unsigned xb_add(unsigned* p, unsigned v) { return __hip_atomic_fetch_add(p, v, __ATOMIC_RELAXED, __HIP_MEMORY_SCOPE_AGENT); }
__device__ __forceinline__ unsigned xb_xcc_id() { return (unsigned)__builtin_amdgcn_s_getreg((3 << 11) | 20) & 0xFu; }
#define XB_SPIN(cond, bar) do { unsigned _sp = 0; while (cond) { __builtin_amdgcn_s_sleep(1); \
    if ((++_sp & 255u) == 0u) { if (xb_ld(&(bar)[XB_TMO])) break; if (_sp > XB_SPIN_CAP) { atomicAdd(&(bar)[XB_TMO], 1u); break; } } } } while (0)

struct XcdBarrier {
    unsigned* bar; unsigned x;
    volatile LAS unsigned* st;
};

__device__ __forceinline__ XcdBarrier xcd_barrier_post(unsigned* bar, volatile LAS unsigned* st, bool leader) {
    XcdBarrier b; b.bar = bar; b.x = xb_xcc_id(); b.st = st;
    if (leader) (void)xb_add(&bar[XB_XCNT(b.x)], 1u);
    return b;
}
__device__ __forceinline__ void xcd_barrier_complete(unsigned* bar, unsigned x, unsigned& nloc, unsigned& nx) {
    const unsigned G = gridDim.x * gridDim.y * gridDim.z;
    unsigned sum, cnt, mine, sp = 0u;
    for (;;) {
        sum = 0u; cnt = 0u; mine = 0u;
#pragma unroll
        for (unsigned j = 0; j < 16; ++j) { const unsigned c = xb_ld(&bar[XB_XCNT(j)]); sum += c; cnt += (c > 0u) ? 1u : 0u; mine = (j == x) ? c : mine; }
        if (sum == G) break;
        __builtin_amdgcn_s_sleep(1);
        if ((++sp & 255u) == 0u) { if (xb_ld(&bar[XB_TMO])) break; if (sp > XB_SPIN_CAP) { atomicAdd(&bar[XB_TMO], 1u); break; } }
    }
    nloc = mine > 0u ? mine : 1u; nx = cnt > 0u ? cnt : 1u;
}

__device__ __forceinline__ void xcd_barrier(const XcdBarrier& b, bool leader) {
    asm volatile("s_waitcnt vmcnt(0)" ::: "memory");
    __syncthreads();
    if (leader) {
        unsigned* bar = b.bar;
        __builtin_amdgcn_s_waitcnt(0);
        unsigned nloc = b.st[0], nx = b.st[1];
        if (nloc == 0u) { xcd_barrier_complete(bar, b.x, nloc, nx); b.st[0] = nloc; b.st[1] = nx; }
        const unsigned old = xb_add(&bar[XB_XSUB(b.x)], 1u);
        const unsigned gen = old / nloc;
        if (old + 1u == (gen + 1u) * nloc) {
            __builtin_amdgcn_fence(__ATOMIC_RELEASE, "agent");
            asm volatile("s_waitcnt vmcnt(0)" ::: "memory");
            const unsigned og = xb_add(&bar[XB_TOP], 1u);
            const unsigned tg = og / nx;
            if (og + 1u == (tg + 1u) * nx) xb_add(&bar[XB_TOPGEN], 1u);
            else XB_SPIN(xb_ld(&bar[XB_TOPGEN]) == tg, bar);
            __builtin_amdgcn_fence(__ATOMIC_ACQUIRE, "agent");
            xb_add(&bar[XB_XGEN(b.x)], 1u);
            asm volatile("s_waitcnt vmcnt(0)" ::: "memory");
        } else {
            XB_SPIN(xb_ld(&bar[XB_XGEN(b.x)]) == gen, bar);
            __builtin_amdgcn_fence(__ATOMIC_ACQUIRE, "agent");
            asm volatile("s_waitcnt vmcnt(0)" ::: "memory");
        }
    }
    __syncthreads();
}

#ifdef DBG_STOP
#define DBG_AT(k, buf) do { if (DBG_STOP == (k) && l == 0) { GRID_SYNC(); PHASE_ARGS(); const bfu* src_ = (const bfu*)(ws + (buf)); float* o_ = ap->out; \
    TID_NOW(tid_); for (size_t i_ = (size_t)bx * 512 + tid_; i_ < (size_t)MTOK * DM; i_ += (size_t)G * 512) o_[i_] = bf2f(src_[i_]); return; } } while (0)
#define DBG_ATF(k, buf) do { if (DBG_STOP == (k) && l == 0) { GRID_SYNC(); PHASE_ARGS(); const float* src_ = (const float*)(ws + (buf)); float* o_ = ap->out; \
    TID_NOW(tid_); for (size_t i_ = (size_t)bx * 512 + tid_; i_ < (size_t)MTOK * DM; i_ += (size_t)G * 512) o_[i_] = src_[i_ >> 10]; return; } } while (0)
#else
#define DBG_ATF(k, buf) do {} while (0)
#define DBG_AT(k, buf) do {} while (0)
#endif
__global__ void __launch_bounds__(512, 2) fwd_megakernel(Args a_unused) {
    extern __shared__ __attribute__((aligned(16))) unsigned char lds_raw[];
    cg::grid_group grid = cg::this_grid();
    LAS unsigned char* lds = (LAS unsigned char*)lds_raw;
    const int wave_s = __builtin_amdgcn_readfirstlane((int)threadIdx.x >> 6);
#define TID_NOW(v) int v; asm volatile("v_mbcnt_lo_u32_b32 %0, -1, 0\n\tv_mbcnt_hi_u32_b32 %0, -1, %0" : "=v"(v)); v += wave_s * 64
    const int G = gridDim.x, bx = blockIdx.x;

    { TID_NOW(t0_); if (t0_ < 2) ((volatile LAS unsigned*)(lds + (LDS_BYTES - 64)))[t0_] = 0u; __syncthreads();
      kargs_t apb_ = (kargs_t)__builtin_amdgcn_kernarg_segment_ptr(); (void)xcd_barrier_post((unsigned*)(apb_->ws + WS_BAR), (volatile LAS unsigned*)(lds + (LDS_BYTES - 64)), t0_ == 0); }
    { PHASE_ARGS(); TID_NOW(tl); prologue(ap, lds, bx * 8 + (tl >> 6), G * 8, tl >> 6, tl & 63); }
    if (G == 0x7fffffff) grid.sync();
    GRID_SYNC();

    for (int ph = 0; ph < 9 * NLAYER; ++ph) { const int l = ph / 9, sub = ph - 9 * l;
        if (sub == 0) {
        { PHASE_ARGS(); TID_NOW(tl); const bfu* WL = (const bfu*)(ws + WS_W) + (size_t)l * WL_ELEMS; const bfu* xb = (const bfu*)(ws + WS_XB);
          pg8::Gemm g{xb, xb, xb, xb, WL + WO_UP1, WL + WO_UP1, WL + WO_UP1, WL + WO_UP1, 1024}; pg8::StaticOrder S; S.init(MTOK, 5632, G, bx, 1);
          pg8::EpiUp E{(bfu*)(ws + WS_ACT), (const float*)(ws + WS_RSQ) + (size_t)((3 * l) & 1) * 16 * MTOK};
          pg8::gemm_phase<pg8::EpiUp, pg8::StaticOrder, true, true>(lds, g, S, E, tl); }
        } else if (sub == 1) {
        { PHASE_ARGS(); TID_NOW(tl); const bfu* WL = (const bfu*)(ws + WS_W) + (size_t)l * WL_ELEMS; const bfu* act = (const bfu*)(ws + WS_ACT);
          pg8::Gemm g{act, act, act, act, WL + WO_DN1, WL + WO_DN1, WL + WO_DN1, WL + WO_DN1, 2816}; pg8::StaticOrder S; S.init(MTOK, 1024, G, bx, 1);
          pg8::EpiRes E{l == 0 ? ap->in[0] : (const float*)ap->out, ap->out, (bfu*)(ws + WS_XB), (float*)(ws + WS_RSQ) + (size_t)((3 * l + 1) & 1) * 16 * MTOK, 0.5f};
          pg8::gemm_phase<pg8::EpiRes, pg8::StaticOrder, true, true>(lds, g, S, E, tl); }
        } else if (sub == 2) {
        { PHASE_ARGS(); TID_NOW(tl); const bfu* WL = (const bfu*)(ws + WS_W) + (size_t)l * WL_ELEMS; const bfu* xb = (const bfu*)(ws + WS_XB);
          pg8::Gemm g{xb, xb, xb, xb, WL + WO_IN, WL + WO_IN, WL + WO_IN, WL + WO_IN, 1024}; pg8::StaticOrder S; S.init(MTOK, NZ - 256, G, bx, 1);
          pg8::EpiZ E{(bfu*)(ws + WS_ZLX), (bfu*)(ws + WS_G), (bfu*)(ws + WS_Q), (bfu*)(ws + WS_K), (bfu*)(ws + WS_V), (float*)(ws + WS_LOGF), (const float*)(ws + WS_RSQ) + (size_t)((3 * l + 1) & 1) * 16 * MTOK,
                      ap->in[14] + l * 64, ap->in[15] + l * 64, ap->in[16] + l * 16, attn_body::C2, (float*)(ws + WS_RSTD2)};
          pg8::gemm_phase<pg8::EpiZ, pg8::StaticOrder, true, true>(lds, g, S, E, tl); }
        } else if (sub == 3) {
        { PHASE_ARGS(); TID_NOW(tl); const bfu* WL = (const bfu*)(ws + WS_W) + (size_t)l * WL_ELEMS;
          forget_phase((const bfu*)(ws + WS_XB), WL + WO_IN + (size_t)5120 * 1024, (const float*)(ws + WS_RSQ) + (size_t)((3 * l + 1) & 1) * 16 * MTOK, ap->in[16] + l * 16, (float*)(ws + WS_LOGF), (float*)(ws + WS_RSTD2), bx, G, tl); }
        } else if (sub == 4) {
        { PHASE_ARGS();
          for (int grp = bx; grp < NB * 16; grp += G) {
            TID_NOW(tl);
            const int b = grp >> 4, q = (grp & 15) >> 2, side = grp & 3;
            const float* bfp = ap->in[16] + l * 16;
            int h0 = 0, h1 = 0, h2 = 0, h3 = 0;
            for (int h = 0; h < 16; ++h) { const float v = bfp[h]; int rk = 0;
                for (int j = 0; j < 16; ++j) { const float w = bfp[j]; rk += (w > v || (w == v && j < h)) ? 1 : 0; }
                if (rk == q) h0 = h; if (rk == 7 - q) h1 = h; if (rk == 8 + q) h2 = h; if (rk == 15 - q) h3 = h; }
            bias_table(lds, (const float*)(ws + WS_LOGF), ap->in[14] + l * 64, ap->in[15] + l * 64, b, h0, tl, 0);
            bias_table(lds, (const float*)(ws + WS_LOGF), ap->in[14] + l * 64, ap->in[15] + l * 64, b, h1, tl, 1);
            bias_table(lds, (const float*)(ws + WS_LOGF), ap->in[14] + l * 64, ap->in[15] + l * 64, b, h2, tl, 2);
            bias_table(lds, (const float*)(ws + WS_LOGF), ap->in[14] + l * 64, ap->in[15] + l * 64, b, h3, tl, 3);
            const float qkmax = __builtin_bit_cast(float, __builtin_amdgcn_readfirstlane(__builtin_bit_cast(int, ((const LAS float*)(lds + ATT_SCR_OFF))[8])));
            unsigned long long tsp0 = 0ull, tsp1 = 0ull; unsigned mine = 0u; int ld0 = 0, ld1 = 0, ld2 = 0, ld3 = 0;
            for (int u = 0; u < 32; ++u) { const int qb = 7 - (u >> 2), hs = u & 3;
                const LAS float* nbL = (const LAS float*)(lds + attn_body::LDS_NB + hs * ATT_TBL_BYTES);
                const float lim = __builtin_bit_cast(float, __builtin_amdgcn_readfirstlane(__builtin_bit_cast(int, nbL[256 * qb]))) - (2.0f * qkmax + 40.0f);
                int ts = 0;
                while (ts + 2 <= 4 * qb && __builtin_bit_cast(float, __builtin_amdgcn_readfirstlane(__builtin_bit_cast(int, nbL[64 * (ts + 1) + 63]))) < lim) ts += 2;
                const int cost = (4 * qb + 4 - ts) + 4;
                int owner = 0, best = ld0; if (ld1 < best) { best = ld1; owner = 1; } if (ld2 < best) { best = ld2; owner = 2; } if (ld3 < best) { best = ld3; owner = 3; }
                ld0 += owner == 0 ? cost : 0; ld1 += owner == 1 ? cost : 0; ld2 += owner == 2 ? cost : 0; ld3 += owner == 3 ? cost : 0;
                if (owner == side) mine |= 1u << u;
                if (u < 16) tsp0 |= (unsigned long long)(ts >> 1) << (4 * u); else tsp1 |= (unsigned long long)(ts >> 1) << (4 * (u - 16)); }
            for (int u = 0; u < 32; ++u) { if (!((mine >> u) & 1u)) continue;
                const int qb = 7 - (u >> 2), hs = u & 3, ts = (int)(((u < 16 ? tsp0 >> (4 * u) : tsp1 >> (4 * (u - 16)))) & 15ull) * 2;
                const int hh = hs == 0 ? h0 : hs == 1 ? h1 : hs == 2 ? h2 : h3;
                attn_body::attn_unit<64>(b, hh, qb, (const attn_body::bf16*)(ws + WS_Q), (const attn_body::bf16*)(ws + WS_K), (const attn_body::bf16*)(ws + WS_V), (attn_body::bf16*)(ws + WS_Q), (char*)lds_raw, tl, ts, hs * ATT_TBL_BYTES); }
            __syncthreads();
          }
        }
        { PHASE_ARGS();
          for (int it = bx; it < NB * 16; it += G) { TID_NOW(tl);
            scan_item(lds, it >> 4, (it >> 1) & 7, it & 1, (const bfu*)(ws + WS_ZLX), (bfu*)(ws + WS_G), ap->in[7] + (size_t)l * 4096, ap->in[8] + l * 1024, ap->in[9] + (size_t)l * 131072, ap->in[10] + l * 1024,
                      ap->in[11] + (size_t)l * 131072, ap->in[12] + l * 1024, ap->in[13] + l * 1024, tl); } }
        } else if (sub == 5) {
        { PHASE_ARGS(); TID_NOW(tl); const bfu* WL = (const bfu*)(ws + WS_W) + (size_t)l * WL_ELEMS; const bfu* xb = (const bfu*)(ws + WS_XB);
          pg8::Gemm g{xb, xb, (const bfu*)(ws + WS_G), (const bfu*)(ws + WS_Q), WL + WO_GATE, WL + WO_GATE + (size_t)1024 * 1024, WL + WO_LRU, WL + WO_ATT, 1024}; pg8::StaticOrder S; S.init(MTOK, 1024, G, bx, 4);
          pg8::EpiMerge E{(bfu*)(ws + WS_K), (bfu*)(ws + WS_V), (bfu*)(ws + WS_ZLX), (const float*)(ws + WS_RSTD2), ap->in[6] + l * 2048};
          pg8::gemm_phase<pg8::EpiMerge, pg8::StaticOrder, true, true>(lds, g, S, E, tl); }
        } else if (sub == 6) {
        { PHASE_ARGS(); TID_NOW(tl); const bfu* WL = (const bfu*)(ws + WS_W) + (size_t)l * WL_ELEMS; const bfu* mb = (const bfu*)(ws + WS_ZLX);
          pg8::Gemm g{mb, mb, mb, mb, WL + WO_O, WL + WO_O, WL + WO_O, WL + WO_O, 1024}; pg8::StaticOrder S; S.init(MTOK, 1024, G, bx, 1);
          pg8::EpiRes E{ap->out, ap->out, (bfu*)(ws + WS_XB), (float*)(ws + WS_RSQ) + (size_t)((3 * l + 2) & 1) * 16 * MTOK, 1.0f};
          pg8::gemm_phase<pg8::EpiRes, pg8::StaticOrder, true, true>(lds, g, S, E, tl); }
        } else if (sub == 7) {
        { PHASE_ARGS(); TID_NOW(tl); const bfu* WL = (const bfu*)(ws + WS_W) + (size_t)l * WL_ELEMS; const bfu* xb = (const bfu*)(ws + WS_XB);
          pg8::Gemm g{xb, xb, xb, xb, WL + WO_UP2, WL + WO_UP2, WL + WO_UP2, WL + WO_UP2, 1024}; pg8::StaticOrder S; S.init(MTOK, 5632, G, bx, 1);
          pg8::EpiUp E{(bfu*)(ws + WS_ACT), (const float*)(ws + WS_RSQ) + (size_t)((3 * l + 2) & 1) * 16 * MTOK};
          pg8::gemm_phase<pg8::EpiUp, pg8::StaticOrder, true, true>(lds, g, S, E, tl); }
        } else {
        { PHASE_ARGS(); TID_NOW(tl); const bfu* WL = (const bfu*)(ws + WS_W) + (size_t)l * WL_ELEMS; const bfu* act = (const bfu*)(ws + WS_ACT);
          const bool more = (l + 1 < NLAYER);
          pg8::Gemm g{act, act, act, act, WL + WO_DN2, WL + WO_DN2, WL + WO_DN2, WL + WO_DN2, 2816}; pg8::StaticOrder S; S.init(MTOK, 1024, G, bx, 1);
          pg8::EpiRes E{ap->out, ap->out, more ? (bfu*)(ws + WS_XB) : nullptr, more ? (float*)(ws + WS_RSQ) + (size_t)((3 * l + 3) & 1) * 16 * MTOK : nullptr, 0.5f};
          pg8::gemm_phase<pg8::EpiRes, pg8::StaticOrder, true, true>(lds, g, S, E, tl); }
        }
        if (ph + 1 < 9 * NLAYER) GRID_SYNC();
    }
}

extern "C" void kernel_launch(void* const* d_in, const int* in_sizes, int n_in, void* d_out, int out_size, void* d_ws, size_t ws_size, hipStream_t stream) {
    static int grid = 0;
    if (grid == 0) {
        if (n_in != 23 || out_size != MTOK * DM || ws_size < WS_END) { fprintf(stderr, "kernel_launch: unexpected problem (n_in %d out %d ws %zu)\n", n_in, out_size, ws_size); grid = -1; return; }
        int dev = 0, cus = 0, per_cu = 0;
        if (hipGetDevice(&dev) != hipSuccess || hipDeviceGetAttribute(&cus, hipDeviceAttributeMultiprocessorCount, dev) != hipSuccess) { grid = -1; return; }
        if (hipFuncSetAttribute((const void*)fwd_megakernel, hipFuncAttributeMaxDynamicSharedMemorySize, LDS_BYTES) != hipSuccess) { fprintf(stderr, "kernel_launch: hipFuncSetAttribute failed\n"); grid = -1; return; }
        if (hipOccupancyMaxActiveBlocksPerMultiprocessor(&per_cu, (const void*)fwd_megakernel, 512, LDS_BYTES) != hipSuccess || per_cu < 1) { fprintf(stderr, "kernel_launch: occupancy query gave %d\n", per_cu); per_cu = 1; }
        (void)hipGetLastError();
        grid = cus * per_cu;
    }
    if (grid < 0) return;
    if (hipMemsetAsync((char*)d_ws + WS_BAR, 0, BAR_BYTES, stream) != hipSuccess) { fprintf(stderr, "kernel_launch: memset of the barrier words failed\n"); return; }
    Args a{};
    for (int i = 0; i < 23; ++i) a.in[i] = (const float*)d_in[i];
    a.out = (float*)d_out; a.ws = (unsigned char*)d_ws;
    void* args[] = {&a};
    hipError_t e = hipLaunchCooperativeKernel((const void*)fwd_megakernel, dim3(grid), dim3(512), args, LDS_BYTES, stream);
    if (e != hipSuccess) fprintf(stderr, "kernel_launch: cooperative launch failed: %s (grid %d)\n", hipGetErrorString(e), grid);
}
```

```cpp
#include <hip/hip_runtime.h>
#include <hip/hip_cooperative_groups.h>
#include <cstdio>
#include <cstdint>
namespace cg = cooperative_groups;
namespace pg8 {
#define PG8_LAS __attribute__((address_space(3)))
typedef unsigned short bf16_t;
typedef short bf16x8 __attribute__((ext_vector_type(8)));
typedef float f32x4 __attribute__((ext_vector_type(4)));
typedef unsigned u32x4 __attribute__((ext_vector_type(4)));
constexpr int BM = 256, BK = 64, HALF = 128, HTB = HALF * BK * 2  , STAGE_BYTES = 8 * HTB, NXCD = 8, WGM = 8;

__host__ __device__ __forceinline__ int lds_byte(int r, int c) { const int st = (r >> 4) * 2 + (c >> 5), rr = r & 15, cc = c & 31, ob = rr * 64 + cc * 2; return st * 1024 + (ob ^ (((ob >> 9) & 1) << 5)); }
__host__ __device__ __forceinline__ void stage_rc(int b, int& R, int& C) { const int st = b / 1024, sb = b % 1024, swz = sb ^ (((sb >> 9) & 1) << 5); R = (st >> 1) * 16 + swz / 64; C = (st & 1) * 32 + (swz % 64) / 2; }
__host__ __device__ __forceinline__ int perm32(int rho) { const int n = rho >> 4, i = rho & 15; return 8 * (i >> 2) + 4 * n + (i & 3); }

struct Unit { int pm, pn, part, pnb; };
struct Gemm { const bf16_t *A0, *A1, *A2, *A3, *B0, *B1, *B2, *B3; int K; };
__device__ __forceinline__ const char* selA(const Gemm& g, int p) { return (const char*)(p == 0 ? g.A0 : p == 1 ? g.A1 : p == 2 ? g.A2 : g.A3); }
__device__ __forceinline__ const char* selB(const Gemm& g, int p) { return (const char*)(p == 0 ? g.B0 : p == 1 ? g.B1 : p == 2 ? g.B2 : g.B3); }

struct StaticOrder {
    int nM, nN, nwg, G, c, np, gp;
    __host__ __device__ void init(int M, int N, int G_, int c_, int np_, int gp_ = 0) { nM = M / BM; nN = N / BM; nwg = nM * nN; G = G_; c = c_; np = np_; gp = gp_; }
    __host__ __device__ bool next(int i, Unit& u) const {
        const int it = i / np; u.part = i - it * np;
        const long L = (long)it * G + c; if (L >= nwg) return false;
        int wgid = (int)L; { const int q = nwg / NXCD, r = nwg % NXCD, xcd = wgid % NXCD, off = wgid / NXCD; wgid = (xcd < r ? xcd * (q + 1) : r * (q + 1) + (xcd - r) * q) + off; }
        const int nig = WGM * nN, gid = wgid / nig, fm = gid * WGM, gsz = (nM - fm) < WGM ? (nM - fm) : WGM;
        u.pm = fm + ((wgid % nig) % gsz); u.pn = (wgid % nig) / gsz; u.pnb = (gp && u.part >= 2) ? 2 * u.pn + (u.part - 2) : u.pn; return true;
    }
    __device__ __forceinline__ void a_ready(const Unit&) const {}
    __device__ __forceinline__ void done(const Unit&) const {}
};

typedef float f32x2 __attribute__((ext_vector_type(2))); typedef __bf16 bf16x2v __attribute__((ext_vector_type(2)));
__device__ __forceinline__ unsigned cvt_pk_bf16(float lo, float hi) { const f32x2 v = {lo, hi}; const bf16x2v b = __builtin_convertvector(v, bf16x2v); return __builtin_bit_cast(unsigned, b); }
__device__ __forceinline__ f32x2 gelu_pk(f32x2 v) {
    const f32x2 av = __builtin_elementwise_abs(v), d = av * 0.2316418882f + 1.0f;
    f32x2 t; t.x = __builtin_amdgcn_rcpf(d.x); t.y = __builtin_amdgcn_rcpf(d.y);
    f32x2 q = t * 0.5307027145f + (-0.7265760135f); q = q * t + 0.7107068705f; q = q * t + (-0.142248368f); q = q * t + 0.127414796f; q = q * t;
    const f32x2 s = (v * v) * (-0.72134752044f);
    f32x2 e; e.x = __builtin_amdgcn_exp2f(s.x); e.y = __builtin_amdgcn_exp2f(s.y);
    const f32x2 m = v * (q * e), r = v - m;
    f32x2 o; o.x = v.x < 0.f ? m.x : r.x; o.y = v.y < 0.f ? m.y : r.y; return o;
}
constexpr float kLog2e = 1.4426950408889634f;
__device__ __forceinline__ float sigm(float x) { return __builtin_amdgcn_rcpf(1.0f + __builtin_amdgcn_exp2f(-kLog2e * x)); }
__device__ __forceinline__ float gelu_tanh(float x) { const float u = x * (1.0f + 0.044715f * x * x); return x * sigm(1.5957691216057308f * u); }
__device__ __forceinline__ void st8(bf16_t* p, const f32x4 a, const f32x4 b) { u32x4 w; w.x = cvt_pk_bf16(a[0], a[1]); w.y = cvt_pk_bf16(a[2], a[3]); w.z = cvt_pk_bf16(b[0], b[1]); w.w = cvt_pk_bf16(b[2], b[3]); *(u32x4*)p = w; }
__device__ __forceinline__ u32x4 ldg16_l2(const void* p) { const unsigned long long lo = __hip_atomic_load((const unsigned long long*)p, __ATOMIC_RELAXED, __HIP_MEMORY_SCOPE_AGENT), hi = __hip_atomic_load((const unsigned long long*)p + 1, __ATOMIC_RELAXED, __HIP_MEMORY_SCOPE_AGENT);
    u32x4 w; w.x = (unsigned)lo; w.y = (unsigned)(lo >> 32); w.z = (unsigned)hi; w.w = (unsigned)(hi >> 32); return w; }
__device__ __forceinline__ void unpk8(const u32x4 w, f32x4& a, f32x4& b) {
    a[0] = __uint_as_float(w.x << 16); a[1] = __uint_as_float(w.x & 0xffff0000u); a[2] = __uint_as_float(w.y << 16); a[3] = __uint_as_float(w.y & 0xffff0000u);
    b[0] = __uint_as_float(w.z << 16); b[1] = __uint_as_float(w.z & 0xffff0000u); b[2] = __uint_as_float(w.w << 16); b[3] = __uint_as_float(w.w & 0xffff0000u); }
__device__ __forceinline__ void ld8(const bf16_t* p, f32x4& a, f32x4& b) { const u32x4 w = *(const u32x4*)p;
    a[0] = __uint_as_float(w.x << 16); a[1] = __uint_as_float(w.x & 0xffff0000u); a[2] = __uint_as_float(w.y << 16); a[3] = __uint_as_float(w.y & 0xffff0000u);
    b[0] = __uint_as_float(w.z << 16); b[1] = __uint_as_float(w.z & 0xffff0000u); b[2] = __uint_as_float(w.w << 16); b[3] = __uint_as_float(w.w & 0xffff0000u); }
constexpr int RSQ_ROWS = 32768;
struct Rs8 { float v[2][4]; };
__device__ __forceinline__ Rs8 load_rstd8(const float* rowsq, int pm, int wr, int fr, int fq) { Rs8 r; f32x4 t[2][4];
    _Pragma("unroll") for (int ai = 0; ai < 2; ++ai) _Pragma("unroll") for (int m = 0; m < 4; ++m) t[ai][m] = *(const f32x4*)(rowsq + (size_t)(pm * BM + ai * HALF + wr * 64 + m * 16 + fr) * 16 + 4 * fq);
    const int ln = fq * 16 + fr;
    _Pragma("unroll") for (int ai = 0; ai < 2; ++ai) _Pragma("unroll") for (int m = 0; m < 4; ++m) { float s = (t[ai][m][0] + t[ai][m][1]) + (t[ai][m][2] + t[ai][m][3]);
        s += __builtin_bit_cast(float, __builtin_amdgcn_ds_bpermute((ln ^ 16) << 2, __builtin_bit_cast(int, s))); s += __builtin_bit_cast(float, __builtin_amdgcn_ds_bpermute((ln ^ 32) << 2, __builtin_bit_cast(int, s)));
        r.v[ai][m] = __builtin_amdgcn_rsqf(s * (1.0f / 1024.0f) + 1e-6f); }
    return r; }
__device__ __forceinline__ Rs8 load_rstd8_direct(const float* rstd, int pm, int wr, int fr) { Rs8 r;
    _Pragma("unroll") for (int ai = 0; ai < 2; ++ai) _Pragma("unroll") for (int m = 0; m < 4; ++m) r.v[ai][m] = rstd[pm * BM + ai * HALF + wr * 64 + m * 16 + fr];
    return r; }
__device__ __forceinline__ float bperm(int srclane, float v) { return __builtin_bit_cast(float, __builtin_amdgcn_ds_bpermute(srclane << 2, __builtin_bit_cast(int, v))); }
#define EPI_ROWS(...) _Pragma("unroll") for (int ai = 0; ai < 2; ++ai) _Pragma("unroll") for (int m = 0; m < 4; ++m) { const int row = u.pm * BM + ai * HALF + wr * 64 + m * 16 + fr; __VA_ARGS__ }

struct EpiUp {
    static constexpr bool PERM = true, AFTER_DRAIN = false;
    bf16_t* O; const float* rowsq;
    __device__ __forceinline__ void operator()(const f32x4 (&acc)[2][2][4][2], const Unit& u, int wr, int wc, int fr_in, int fq_in) const {
        int fr = fr_in, fq = fq_in; asm volatile("" : "+v"(fr), "+v"(fq));
        const int col = u.pn * 128 + wc * 32 + 8 * fq; const Rs8 R = load_rstd8(rowsq, u.pm, wr, fr, fq);
        EPI_ROWS(
            const float rs = R.v[ai][m];
            f32x4 o[2];
            _Pragma("unroll") for (int n = 0; n < 2; ++n) { const f32x4 g = acc[ai][0][m][n] * rs, up = acc[ai][1][m][n] * rs;
                _Pragma("unroll") for (int j = 0; j < 4; ++j) o[n][j] = g[j] * sigm(g[j]) * up[j]; }
            st8(O + (size_t)row * 2816 + col, o[0], o[1]);
        )
    }
};
struct EpiRes {
    static constexpr bool PERM = true, AFTER_DRAIN = false;
    const float* base; float* out; bf16_t* xb; float* rsq_next; float scale;
    __device__ __forceinline__ void operator()(const f32x4 (&acc)[2][2][4][2], const Unit& u, int wr, int wc, int fr_in, int fq_in) const {
        int fr = fr_in, fq = fq_in; asm volatile("" : "+v"(fr), "+v"(fq));
        const int col = u.pn * BM + wc * 32 + 8 * fq;
#pragma unroll
        for (int ai = 0; ai < 2; ++ai) { f32x4 bs[4][2][2];
#pragma unroll
            for (int m = 0; m < 4; ++m)
#pragma unroll
                for (int bj = 0; bj < 2; ++bj) { const size_t off = (size_t)(u.pm * BM + ai * HALF + wr * 64 + m * 16 + fr) * 1024 + col + bj * HALF; bs[m][bj][0] = *(const f32x4*)(base + off); bs[m][bj][1] = *(const f32x4*)(base + off + 4); }
#pragma unroll
            for (int m = 0; m < 4; ++m) { const int row = u.pm * BM + ai * HALF + wr * 64 + m * 16 + fr; float ss = 0.f;
#pragma unroll
                for (int bj = 0; bj < 2; ++bj) { const size_t off = (size_t)row * 1024 + col + bj * HALF;
                    const f32x4 o0 = bs[m][bj][0] + acc[ai][bj][m][0] * scale, o1 = bs[m][bj][1] + acc[ai][bj][m][1] * scale;
                    *(f32x4*)(out + off) = o0; *(f32x4*)(out + off + 4) = o1;
                    ss += (o0[0] * o0[0] + o0[1] * o0[1]) + (o0[2] * o0[2] + o0[3] * o0[3]) + (o1[0] * o1[0] + o1[1] * o1[1]) + (o1[2] * o1[2] + o1[3] * o1[3]);
                    if (xb) st8(xb + off, o0, o1); }
                if (rsq_next) { const int ln = fq * 16 + fr; ss += bperm(ln ^ 16, ss); ss += bperm(ln ^ 32, ss); if (fq == 0) rsq_next[(size_t)row * 16 + u.pn * 4 + wc] = ss; } }
            asm volatile("" ::: "memory"); }
    }
};
struct EpiZ {
    static constexpr bool PERM = true, AFTER_DRAIN = false;
    bf16_t *ZLX, *G, *Q, *Kb, *V; float* logf; const float* rowsq; const float *gq, *gk, *bforget; float c2; float* rstd2;
    __device__ __forceinline__ void operator()(const f32x4 (&acc)[2][2][4][2], const Unit& u, int wr, int wc, int fr_in, int fq_in) const {
        int fr = fr_in, fq = fq_in; asm volatile("" : "+v"(fr), "+v"(fq));
        const int t = u.pn >> 2, pnl = u.pn & 3; const Rs8 R = load_rstd8(rowsq, u.pm, wr, fr, fq);
        if (t == 0 || t == 4) { bf16_t* O = t == 0 ? ZLX : V; const int col = pnl * BM + wc * 32 + 8 * fq;
            EPI_ROWS( const float rs = R.v[ai][m];
                _Pragma("unroll") for (int bj = 0; bj < 2; ++bj) st8(O + (size_t)row * 1024 + col + bj * HALF, acc[ai][bj][m][0] * rs, acc[ai][bj][m][1] * rs); )
        } else if (t == 1) { const int col = pnl * BM + wc * 32 + 8 * fq;
            EPI_ROWS( const float rs = R.v[ai][m];
                _Pragma("unroll") for (int bj = 0; bj < 2; ++bj) { f32x4 o[2];
                    _Pragma("unroll") for (int n = 0; n < 2; ++n) _Pragma("unroll") for (int j = 0; j < 4; ++j) o[n][j] = gelu_tanh(acc[ai][bj][m][n][j] * rs);
                    st8(G + (size_t)row * 1024 + col + bj * HALF, o[0], o[1]); } )
        } else if (t == 2 || t == 3) {
            bf16_t* O = t == 2 ? Q : Kb; const float* gn = t == 2 ? gq : gk; const float sc = t == 2 ? c2 : 1.0f;
            const int col = (pnl * 4 + wc) * 64 + 8 * fq;
            f32x4 gv[2][2];
            _Pragma("unroll") for (int bj = 0; bj < 2; ++bj) _Pragma("unroll") for (int n = 0; n < 2; ++n) gv[bj][n] = *(const f32x4*)(gn + 32 * bj + 8 * fq + 4 * n) * sc;
            EPI_ROWS( const float rs = R.v[ai][m];
                f32x4 v[2][2]; float ss = 0.f;
                _Pragma("unroll") for (int bj = 0; bj < 2; ++bj) _Pragma("unroll") for (int n = 0; n < 2; ++n) { v[bj][n] = acc[ai][bj][m][n] * rs; const f32x4 q = v[bj][n] * v[bj][n]; ss += (q[0] + q[1]) + (q[2] + q[3]); }
                { const int ln = fq * 16 + fr; ss += bperm(ln ^ 16, ss); ss += bperm(ln ^ 32, ss); }
                const float rn = __builtin_amdgcn_rsqf(ss * (1.0f / 64.0f) + 1e-6f);
                _Pragma("unroll") for (int bj = 0; bj < 2; ++bj) st8(O + (size_t)row * 1024 + col + 32 * bj, v[bj][0] * rn * gv[bj][0], v[bj][1] * rn * gv[bj][1]); )
        } else {
            if (wc == 0 && fq < 2) {
                f32x4 bf0 = *(const f32x4*)(bforget + 8 * fq), bf1 = *(const f32x4*)(bforget + 8 * fq + 4);
                EPI_ROWS( const float rs = R.v[ai][m]; f32x4 o[2];
                    _Pragma("unroll") for (int n = 0; n < 2; ++n) _Pragma("unroll") for (int j = 0; j < 4; ++j) { const float x = acc[ai][0][m][n][j] * rs + (n == 0 ? bf0[j] : bf1[j]);
                        o[n][j] = fminf(x, 0.f) - log1pf(__expf(-fabsf(x))); }
                    *(f32x4*)(logf + (size_t)row * 16 + 8 * fq) = o[0]; *(f32x4*)(logf + (size_t)row * 16 + 8 * fq + 4) = o[1]; if (fq == 0) rstd2[row] = rs; )
            }
        }
    }
};
struct EpiMerge {
    static constexpr bool PERM = true, AFTER_DRAIN = false;
    bf16_t *Y1, *Y2, *MB; const float* rstd2; const float* bgate;
    __device__ __forceinline__ void operator()(const f32x4 (&acc)[2][2][4][2], const Unit& u, int wr, int wc, int fr_in, int fq_in) const {
        int fr = fr_in, fq = fq_in; asm volatile("" : "+v"(fr), "+v"(fq));
        if (u.part < 2) { bf16_t* O = u.part == 0 ? Y1 : Y2; const int col = u.pn * BM + wc * 32 + 8 * fq;
            EPI_ROWS( _Pragma("unroll") for (int bj = 0; bj < 2; ++bj) st8(O + (size_t)row * 1024 + col + bj * HALF, acc[ai][bj][m][0], acc[ai][bj][m][1]); )
        } else {
            const int col = u.pn * BM + (u.part - 2) * HALF + wc * 32 + 8 * fq;
            const Rs8 R = load_rstd8_direct(rstd2, u.pm, wr, fr);
            f32x4 ba[2], bb[2];
#pragma unroll
            for (int n = 0; n < 2; ++n) { ba[n] = *(const f32x4*)(bgate + col + 4 * n); bb[n] = *(const f32x4*)(bgate + 1024 + col + 4 * n); }
#pragma unroll
            for (int ai = 0; ai < 2; ++ai) { u32x4 y1w[4], y2w[4];
#pragma unroll
                for (int m = 0; m < 4; ++m) { const size_t off = (size_t)(u.pm * BM + ai * HALF + wr * 64 + m * 16 + fr) * 1024 + col; y1w[m] = *(const u32x4*)(Y1 + off); y2w[m] = *(const u32x4*)(Y2 + off); }
#pragma unroll
                for (int m = 0; m < 4; ++m) { const int row = u.pm * BM + ai * HALF + wr * 64 + m * 16 + fr; const float rs = R.v[ai][m];
                    f32x4 a0, a1, b0, b1; unpk8(y1w[m], a0, a1); unpk8(y2w[m], b0, b1); f32x4 o[2];
#pragma unroll
                    for (int j = 0; j < 4; ++j) {
                        o[0][j] = sigm(acc[ai][0][m][0][j] * rs + ba[0][j]) * a0[j] + sigm(acc[ai][1][m][0][j] * rs + bb[0][j]) * b0[j];
                        o[1][j] = sigm(acc[ai][0][m][1][j] * rs + ba[1][j]) * a1[j] + sigm(acc[ai][1][m][1][j] * rs + bb[1][j]) * b1[j]; }
                    st8(MB + (size_t)row * 1024 + col, o[0], o[1]); }
                asm volatile("" ::: "memory"); }
        }
    }
};
template <class Epi, class Sched, bool ALIGN_EPI = false, bool SP2 = false>
__device__ __forceinline__ void gemm_phase(PG8_LAS unsigned char* lds, const Gemm g, const Sched& S, const Epi& E, const int tid) {
    const int wid = __builtin_amdgcn_readfirstlane(tid >> 6), lane = tid & 63, wr = wid >> 2, wc = wid & 3, fr = lane & 15, fq = lane >> 4;
    const int K = g.K, nt = K / BK;
    unsigned voffA[2], voffB[2];
#pragma unroll
    for (int i = 0; i < 2; ++i) { int R, C; stage_rc(tid * 16 + i * 8192, R, C); const int Rb = Epi::PERM ? ((R & ~31) + perm32(R & 31)) : R;
        voffA[i] = (unsigned)(R * K + C) * 2u; voffB[i] = (unsigned)(Rb * K + C) * 2u; }
    const size_t kstep = (size_t)(BK * 2);
    const size_t hstep = (size_t)HALF * K * 2;
    const size_t tstep = 2 * hstep;
    const unsigned ldsw = (unsigned)wid * 1024u;
    const int aoff = lds_byte(wr * 64 + fr, fq * 8), boff = lds_byte(wc * 32 + fr, fq * 8);
#define PG8_SA(b, h) (((b) * 2 + (h)) * HTB)
#define PG8_SB(b, h) ((4 + (b) * 2 + (h)) * HTB)
#define PG8_STAGE(bufoff, gbase, voff) do { _Pragma("unroll") for (int _i = 0; _i < 2; ++_i) \
        __builtin_amdgcn_global_load_lds((const unsigned*)((const char*)(gbase) + (voff)[_i]), (PG8_LAS unsigned*)(lds + (bufoff) + ldsw + _i * 8192), 16, 0, 0); } while (0)
#define PG8_LDA(dst, b, h) do { _Pragma("unroll") for (int m = 0; m < 4; ++m) _Pragma("unroll") for (int k = 0; k < 2; ++k) dst[m][k] = *(const PG8_LAS bf16x8*)(lds + PG8_SA(b, h) + aoff + m * 2048 + k * 1024); } while (0)
#define PG8_LDB(dst, b, h) do { _Pragma("unroll") for (int n = 0; n < 2; ++n) _Pragma("unroll") for (int k = 0; k < 2; ++k) dst[n][k] = *(const PG8_LAS bf16x8*)(lds + PG8_SB(b, h) + boff + n * 2048 + k * 1024); } while (0)
#define PG8_MMA(ai, bj, At, Bt) do { __builtin_amdgcn_s_setprio(1); _Pragma("unroll") for (int m = 0; m < 4; ++m) _Pragma("unroll") for (int n = 0; n < 2; ++n) _Pragma("unroll") for (int k = 0; k < 2; ++k) \
        acc[ai][bj][m][n] = __builtin_amdgcn_mfma_f32_16x16x32_bf16(Bt[n][k], At[m][k], acc[ai][bj][m][n], 0, 0, 0); __builtin_amdgcn_s_setprio(0); } while (0)
#define PG8_WAIT_V(n) asm volatile("s_waitcnt vmcnt(" #n ")" ::: "memory")
#define PG8_WAIT_L(n) asm volatile("s_waitcnt lgkmcnt(" #n ")" ::: "memory")
#define PG8_BAR __builtin_amdgcn_s_barrier()
#define PG8_SCHED __builtin_amdgcn_sched_barrier(0)
    Unit cur, nxt; int ui = 0;
    if (!S.next(0, cur)) return;
    f32x4 acc[2][2][4][2];
#pragma unroll
    for (int a = 0; a < 2; ++a)
#pragma unroll
        for (int b = 0; b < 2; ++b)
#pragma unroll
            for (int m = 0; m < 4; ++m)
#pragma unroll
                for (int n = 0; n < 2; ++n) acc[a][b][m][n] = (f32x4){0.f, 0.f, 0.f, 0.f};
    bf16x8 At[4][2], B0[2][2], B1[2][2];
    const char* cA = selA(g, cur.part) + (size_t)cur.pm * tstep; const char* cB = selB(g, cur.part) + (size_t)cur.pnb * tstep;
    S.a_ready(cur);
    if constexpr (SP2) {
        PG8_STAGE(PG8_SB(0, 0), cB, voffB); PG8_STAGE(PG8_SB(0, 1), cB + hstep, voffB); PG8_STAGE(PG8_SA(0, 0), cA, voffA); PG8_STAGE(PG8_SA(0, 1), cA + hstep, voffA);
        if (wr == 1) PG8_BAR;
        PG8_WAIT_V(2); PG8_BAR;
        PG8_STAGE(PG8_SB(1, 0), cB + kstep, voffB); PG8_STAGE(PG8_SA(1, 0), cA + kstep, voffA); PG8_STAGE(PG8_SB(1, 1), cB + hstep + kstep, voffB);
        PG8_WAIT_V(6); PG8_BAR;
    } else {
        PG8_STAGE(PG8_SB(0, 0), cB, voffB); PG8_STAGE(PG8_SA(0, 0), cA, voffA); PG8_STAGE(PG8_SB(0, 1), cB + hstep, voffB); PG8_STAGE(PG8_SA(0, 1), cA + hstep, voffA);
        if (wr == 1) PG8_BAR;
        PG8_WAIT_V(4); PG8_BAR;
        PG8_STAGE(PG8_SB(1, 0), cB + kstep, voffB); PG8_STAGE(PG8_SA(1, 0), cA + kstep, voffA); PG8_STAGE(PG8_SB(1, 1), cB + hstep + kstep, voffB);
        PG8_WAIT_V(6); PG8_BAR;
    }
    for (;;) {
        const bool has_next = S.next(ui + 1, nxt);
        const char* nA = has_next ? selA(g, nxt.part) + (size_t)nxt.pm * tstep : cA; const char* nB = has_next ? selB(g, nxt.part) + (size_t)nxt.pnb * tstep : cB;
        for (int t = 0; t < nt; t += 2) {
            const bool last = (t == nt - 2);
            const char* a1 = cA + (size_t)(t + 1) * kstep;
            const char* a2 = last ? nA : cA + (size_t)(t + 2) * kstep; const char* b2 = last ? nB : cB + (size_t)(t + 2) * kstep;
            const char* a3 = a2 + kstep; const char* b3 = b2 + kstep;
            if (last && has_next) S.a_ready(nxt);
            if constexpr (SP2) {
            PG8_LDB(B0, 0, 0); PG8_LDB(B1, 0, 1); PG8_SCHED; PG8_LDA(At, 0, 0); PG8_STAGE(PG8_SA(1, 1), a1 + hstep, voffA);
            PG8_WAIT_V(8); PG8_WAIT_L(0); PG8_BAR; PG8_MMA(0, 0, At, B0); PG8_MMA(0, 1, At, B1); PG8_BAR; PG8_SCHED;
            PG8_LDA(At, 0, 1); PG8_STAGE(PG8_SB(0, 0), b2, voffB); PG8_STAGE(PG8_SB(0, 1), b2 + hstep, voffB); PG8_STAGE(PG8_SA(0, 0), a2, voffA);
            PG8_WAIT_V(8); PG8_WAIT_L(0); PG8_BAR; PG8_MMA(1, 0, At, B0); PG8_MMA(1, 1, At, B1); PG8_BAR; PG8_SCHED;
            PG8_LDB(B0, 1, 0); PG8_LDB(B1, 1, 1); PG8_SCHED; PG8_LDA(At, 1, 0); PG8_STAGE(PG8_SA(0, 1), a2 + hstep, voffA);
            PG8_WAIT_V(8); PG8_WAIT_L(0); PG8_BAR; PG8_MMA(0, 0, At, B0); PG8_MMA(0, 1, At, B1); PG8_BAR; PG8_SCHED;
            PG8_LDA(At, 1, 1); PG8_STAGE(PG8_SB(1, 0), b3, voffB); PG8_STAGE(PG8_SB(1, 1), b3 + hstep, voffB); PG8_STAGE(PG8_SA(1, 0), a3, voffA);
            PG8_WAIT_V(8); PG8_WAIT_L(0); PG8_BAR; PG8_MMA(1, 0, At, B0); PG8_MMA(1, 1, At, B1); PG8_BAR; PG8_SCHED;
            } else {
            PG8_LDB(B0, 0, 0); PG8_SCHED; PG8_LDA(At, 0, 0); PG8_STAGE(PG8_SA(1, 1), a1 + hstep, voffA);
            PG8_WAIT_L(8); PG8_BAR; PG8_WAIT_L(0); PG8_MMA(0, 0, At, B0); PG8_BAR; PG8_SCHED;
            PG8_LDB(B1, 0, 1); PG8_STAGE(PG8_SB(0, 0), b2, voffB);
            PG8_BAR; PG8_WAIT_L(0); PG8_MMA(0, 1, At, B1); PG8_BAR;
            PG8_LDA(At, 0, 1); PG8_STAGE(PG8_SA(0, 0), a2, voffA);
            PG8_BAR; PG8_WAIT_L(0); PG8_MMA(1, 0, At, B0); PG8_BAR; PG8_SCHED;
            PG8_STAGE(PG8_SB(0, 1), b2 + hstep, voffB);
            PG8_WAIT_V(6); PG8_BAR; PG8_MMA(1, 1, At, B1); PG8_BAR;
            PG8_LDB(B0, 1, 0); PG8_SCHED; PG8_LDA(At, 1, 0); PG8_STAGE(PG8_SA(0, 1), a2 + hstep, voffA);
            PG8_WAIT_L(8); PG8_BAR; PG8_WAIT_L(0); PG8_MMA(0, 0, At, B0); PG8_BAR; PG8_SCHED;
            PG8_LDB(B1, 1, 1); PG8_STAGE(PG8_SB(1, 0), b3, voffB);
            PG8_BAR; PG8_WAIT_L(0); PG8_MMA(0, 1, At, B1); PG8_BAR;
            PG8_LDA(At, 1, 1); PG8_STAGE(PG8_SA(1, 0), a3, voffA);
            PG8_BAR; PG8_WAIT_L(0); PG8_MMA(1, 0, At, B0); PG8_BAR; PG8_SCHED;
            PG8_STAGE(PG8_SB(1, 1), b3 + hstep, voffB);
            PG8_WAIT_V(6); PG8_BAR; PG8_MMA(1, 1, At, B1); PG8_BAR;
            }
        }
        if constexpr (ALIGN_EPI) { if (wr == 0) PG8_BAR; }
        if constexpr (!Epi::AFTER_DRAIN) { E(acc, cur, wr, wc, fr, fq); S.done(cur); }
        if (!has_next) break;
#pragma unroll
        for (int a = 0; a < 2; ++a)
#pragma unroll
            for (int b = 0; b < 2; ++b)
#pragma unroll
                for (int m = 0; m < 4; ++m)
#pragma unroll
                    for (int n = 0; n < 2; ++n) acc[a][b][m][n] = (f32x4){0.f, 0.f, 0.f, 0.f};
        cur = nxt; cA = nA; cB = nB; ++ui;
        if constexpr (ALIGN_EPI) { if (wr == 1) PG8_BAR; }
    }
    PG8_WAIT_V(0);
    if constexpr (!ALIGN_EPI) { if (wr == 0) PG8_BAR; }
    PG8_BAR;
    if constexpr (Epi::AFTER_DRAIN) { E.fused(acc, cur, wr, wc, fr, fq, lds, wid, lane); S.done(cur); }
#undef PG8_SA
#undef PG8_SB
#undef PG8_STAGE
#undef PG8_LDA
#undef PG8_LDB
#undef PG8_MMA
#undef PG8_WAIT_V
#undef PG8_WAIT_L
#undef PG8_BAR
#undef PG8_SCHED
}
}

#include <hip/hip_bf16.h>
#include <cmath>
namespace attn_body {
using bf16=__hip_bfloat16;
using bf16x8=__attribute__((ext_vector_type(8)))short;
using s16x4=__attribute__((ext_vector_type(4)))short;
using f32x16=__attribute__((ext_vector_type(16)))float;
using u32x4=__attribute__((ext_vector_type(4)))unsigned;
using f32x4v=__attribute__((ext_vector_type(4)))float;
constexpr int BATCH=16,NHEAD=16,SEQ=2048,D=64,DM=NHEAD*D;
constexpr int NW=8,QBLK=32,QB=QBLK*NW,KVBLK=64,NQB=SEQ/QB;
constexpr int ATTN_PITCH=DM, ATTN_UNIT_ROWS=QB;
__device__ __forceinline__ int crow(int r,int hi){return (r&3)+8*(r>>2)+4*hi;}
#define SBAR() __builtin_amdgcn_sched_barrier(0)
__device__ __forceinline__ void cmask(f32x16&p0,f32x16&p1,int jb,int qrel,int hi){
  const float NEG=-INFINITY; int kb=64*jb+4*hi;
  #pragma unroll
  for(int r=0;r<16;++r){int kv=kb+(r&3)+8*(r>>2); if(kv>qrel)p0[r]=NEG; if(kv+32>qrel)p1[r]=NEG;}
}

constexpr int NSLOT=3, SLOTB=8192;
constexpr int LDS_K=0, LDS_V=NSLOT*SLOTB, LDS_WS=2*NSLOT*SLOTB, LDS_OST=LDS_WS+NW*64*4, LDS_NB=LDS_OST+NW*4096, LDS_BYTES=LDS_NB+(SEQ+64)*4;
constexpr float C2=0.125f*1.4426950408889634f;
__device__ __forceinline__ void glds16s(const void*sbase,unsigned voff,unsigned lds_dst){unsigned keep;
  asm volatile("s_mov_b32 %0, m0\n\ts_mov_b32 m0, %2\n\ts_nop 0\n\tglobal_load_lds_dwordx4 %1, %3\n\ts_mov_b32 m0, %0":"=&s"(keep):"v"(voff),"s"(lds_dst),"s"(sbase):"memory");}
__device__ __forceinline__ void glds16(const void*gsrc,unsigned lds_dst){unsigned keep;
  asm volatile("s_mov_b32 %0, m0\n\ts_mov_b32 m0, %2\n\ts_nop 0\n\tglobal_load_lds_dwordx4 %1, off\n\ts_mov_b32 m0, %0":"=&s"(keep):"v"(gsrc),"s"(lds_dst):"memory");}
__device__ __forceinline__ float max3f(float a,float b,float c){float r;asm("v_max3_f32 %0, %1, %2, %3":"=v"(r):"v"(a),"v"(b),"v"(c));return r;}
__device__ __forceinline__ float max2f(float a,float b){float r;asm("v_max_f32_e32 %0, %1, %2":"=v"(r):"v"(a),"v"(b));return r;}
__device__ __forceinline__ float fadd_s(float a,float b){float r;asm("v_add_f32_e32 %0, %1, %2":"=v"(r):"v"(a),"v"(b));return r;}
__device__ __forceinline__ float fsub_s(float a,float b){float r;asm("v_sub_f32_e32 %0, %1, %2":"=v"(r):"v"(a),"v"(b));return r;}
typedef float f32x2_t __attribute__((ext_vector_type(2))); typedef __bf16 bf16x2_t __attribute__((ext_vector_type(2)));
__device__ __forceinline__ unsigned cvtpk_s(float lo,float hi){f32x2_t v={lo,hi};bf16x2_t b=__builtin_convertvector(v,bf16x2_t);return __builtin_bit_cast(unsigned,b);}
#define WAIT_BAR(N) asm volatile("s_waitcnt vmcnt(" #N ") lgkmcnt(0)\n\ts_barrier":::"memory")

__device__ __forceinline__ void qkt(f32x16&p0,f32x16&p1,const char*Kslot,const bf16x8*qr,int r32,int hi){
  const char*kb=Kslot+hi*1024+r32*16;
  #pragma unroll
  for(int d0=0;d0<4;++d0){
    const bf16x8 b0=*reinterpret_cast<const bf16x8*>(kb+d0*2048);
    const bf16x8 b1=*reinterpret_cast<const bf16x8*>(kb+d0*2048+512);
    p0=__builtin_amdgcn_mfma_f32_32x32x16_bf16(b0,qr[d0],p0,0,0,0);p1=__builtin_amdgcn_mfma_f32_32x32x16_bf16(b1,qr[d0],p1,0,0,0);}
}
typedef __attribute__((address_space(3))) const char* lds_cptr;
typedef short v4i16_t __attribute__((ext_vector_type(4)));
__device__ __forceinline__ void kload8(bf16x8*kf,lds_cptr kp){
  kf[0]=*(const __attribute__((address_space(3))) bf16x8*)(kp);      kf[1]=*(const __attribute__((address_space(3))) bf16x8*)(kp+512);
  kf[2]=*(const __attribute__((address_space(3))) bf16x8*)(kp+2048); kf[3]=*(const __attribute__((address_space(3))) bf16x8*)(kp+2560);
  kf[4]=*(const __attribute__((address_space(3))) bf16x8*)(kp+4096); kf[5]=*(const __attribute__((address_space(3))) bf16x8*)(kp+4608);
  kf[6]=*(const __attribute__((address_space(3))) bf16x8*)(kp+6144); kf[7]=*(const __attribute__((address_space(3))) bf16x8*)(kp+6656);
}
__device__ __forceinline__ void kload2(bf16x8*kf,lds_cptr kp,int j){ kf[2*j]=*(const __attribute__((address_space(3))) bf16x8*)(kp+j*2048); kf[2*j+1]=*(const __attribute__((address_space(3))) bf16x8*)(kp+j*2048+512); }
__device__ __forceinline__ s16x4 vtr(lds_cptr p){ return __builtin_bit_cast(s16x4,__builtin_amdgcn_ds_read_tr16_b64_v4i16((__attribute__((address_space(3))) v4i16_t*)p)); }
__device__ __forceinline__ float rowmax(const f32x16&p0,const f32x16&p1){
  float a=max3f(p0[0],p0[1],p1[0]),b=max3f(p0[2],p0[3],p1[1]);a=max3f(a,p1[2],p1[3]);
  #pragma unroll
  for(int r=4;r<16;r+=4){a=max3f(a,p0[r],p0[r+1]);b=max3f(b,p0[r+2],p0[r+3]);a=max3f(a,p1[r],p1[r+1]);b=max3f(b,p1[r+2],p1[r+3]);}
  const float m=max2f(a,b);
  auto rr=__builtin_amdgcn_permlane32_swap(__float_as_uint(m),__float_as_uint(m),false,false);
  return max2f(__uint_as_float(rr[0]),__uint_as_float(rr[1]));
}
__device__ __forceinline__ void pv(f32x16*o,int vb,bf16x8 pa0,bf16x8 pa1,bf16x8 pa2,bf16x8 pa3){
  #pragma unroll
  for(int d0=0;d0<2;++d0){s16x4 lo[4],hi[4];
    #pragma unroll
    for(int ks=0;ks<4;++ks){
      asm volatile("ds_read_b64_tr_b16 %0,%1 offset:%c2":"=&v"(lo[ks]):"v"(vb),"i"(d0*4096+ks*1024):"memory");
      asm volatile("ds_read_b64_tr_b16 %0,%1 offset:%c2":"=&v"(hi[ks]):"v"(vb),"i"(d0*4096+ks*1024+512):"memory");}
    asm volatile("s_waitcnt lgkmcnt(0)":::"memory");SBAR();
    #define PK(k) (bf16x8){lo[k][0],lo[k][1],lo[k][2],lo[k][3],hi[k][0],hi[k][1],hi[k][2],hi[k][3]}
    o[d0]=__builtin_amdgcn_mfma_f32_32x32x16_bf16(pa0,PK(0),o[d0],0,0,0);
    o[d0]=__builtin_amdgcn_mfma_f32_32x32x16_bf16(pa1,PK(1),o[d0],0,0,0);
    o[d0]=__builtin_amdgcn_mfma_f32_32x32x16_bf16(pa2,PK(2),o[d0],0,0,0);
    o[d0]=__builtin_amdgcn_mfma_f32_32x32x16_bf16(pa3,PK(3),o[d0],0,0,0);
    #undef PK
  }
}

#ifndef ATTN_STORE16
#define ATTN_STORE16(p,v) (*(u32x4*)(p)=(v))
#endif
template<int THRL> __device__ __forceinline__ void attn_unit(int b,int h,int qb,const bf16*Q,const bf16*__restrict__ K,const bf16*__restrict__ V,bf16*O,char*shm,const int tid,const int tstart,const int tbl_off){
  const int lane=tid&63,r32=lane&31,hi=lane>>5; const int wid=__builtin_amdgcn_readfirstlane(tid>>6);
  const long rowbase=(long)b*SEQ; const int q0=qb*QB;
  const bf16*Qw=Q+(rowbase+q0+wid*QBLK)*DM+h*D;
  const bf16*Kh=K+(rowbase+(long)tstart*KVBLK)*DM+h*D,*Vh=V+(rowbase+(long)tstart*KVBLK)*DM+h*D;
  const unsigned lds0=(unsigned)(uintptr_t)shm;
  float*wsf=(float*)(shm+LDS_WS)+wid*64;
  const unsigned koff=(unsigned)(lane*DM+wid*8)*2u;
  const unsigned voffv=(unsigned)((16*(wid&3)+(lane>>2))*DM+(wid>>2)*32+(lane&3)*8)*2u;
  const unsigned kdst=lds0+LDS_K+wid*1024, vdst=lds0+LDS_V+wid*1024;
  #define DMA_K(t,slot) glds16s(Kh+(long)(t)*KVBLK*DM,koff,(unsigned)__builtin_amdgcn_readfirstlane(kdst+(slot)))
  #define DMA_V(t,slot) glds16s(Vh+(long)(t)*KVBLK*DM,voffv,(unsigned)__builtin_amdgcn_readfirstlane(vdst+(slot)))
  const int vb0=(int)(lds0+LDS_V)+((lane>>4)&1)*32+(lane&3)*8+(4*hi+((lane&15)>>2))*64;
  const char*Kbase=shm+LDS_K; bf16x8 kf[8];
  const lds_cptr shm3=(lds_cptr)shm; const lds_cptr kp0=shm3+LDS_K+hi*1024+r32*16; const lds_cptr vp0=shm3+LDS_V+((lane>>4)&1)*32+(lane&3)*8+(4*hi+((lane&15)>>2))*64;
  const int NT=(q0+QB)/KVBLK-tstart;
  typedef __attribute__((address_space(3))) const f32x4v* nb_cptr;
  const nb_cptr nb0=(nb_cptr)(shm3+LDS_NB+tbl_off)+hi+16*tstart;
  #define BLOAD1(X0,t,H) do{ const nb_cptr p_=nb0+16*(t)+8*(H); \
    _Pragma("unroll") for(int j_=0;j_<4;++j_){ const f32x4v a_=p_[2*j_]; \
      X0[4*j_]=a_[0]-mhat;X0[4*j_+1]=a_[1]-mhat;X0[4*j_+2]=a_[2]-mhat;X0[4*j_+3]=a_[3]-mhat; } asm volatile("":"+v"(X0)); }while(0)
  #define BLOAD(X0,X1,t) do{ BLOAD1(X0,t,0); BLOAD1(X1,t,1); }while(0)
  #define BSUB16(X) do{ _Pragma("unroll") for(int r_=0;r_<16;++r_)X[r_]-=mhat; asm volatile("":"+v"(X)); }while(0)
  DMA_K(0,0);DMA_V(0,0);DMA_K(1,SLOTB);
  bf16x8 qr[4];
  #pragma unroll
  for(int d0=0;d0<4;++d0)qr[d0]=*reinterpret_cast<const bf16x8*>(&Qw[(long)r32*DM+d0*16+hi*8]);
  float mhat=0.f,l_reg=0.f;f32x16 o[2];o[0]=f32x16{};o[1]=f32x16{};
  const int qrel=wid*QBLK+r32;
  #define CMASK(P0,P1,t) do{int jb_=(t)-(NT-4); if(jb_>=0)cmask(P0,P1,jb_,qrel,hi);}while(0)
  bool resc=false;
  #define START(P0,P1) do{ const float rm=rowmax(P0,P1); resc=false; \
    { const float dl=rm; mhat=fadd_s(mhat,dl); \
      _Pragma("unroll") for(int r=0;r<16;++r){P0[r]=fsub_s(P0[r],dl);P1[r]=fsub_s(P1[r],dl);} } \
    _Pragma("unroll") for(int r=0;r<16;++r)P0[r]=__builtin_amdgcn_exp2f(P0[r]); }while(0)
  #define RESC() do{ if(resc){ asm volatile("s_waitcnt lgkmcnt(0)":::"memory"); \
      _Pragma("unroll") for(int d_=0;d_<2;++d_) _Pragma("unroll") for(int r=0;r<16;++r)o[d_][r]*=wsf[crow(r,hi)]; } }while(0)
  f32x16 pA0,pA1,pB0,pB1;
  int sl_prev=0,sl_cur=0,sl_next=SLOTB;
  #define ROT() do{sl_prev=sl_cur;sl_cur=sl_next;sl_next=(sl_next==(NSLOT-1)*SLOTB)?0:sl_next+SLOTB;}while(0)
  DMA_K(2,2*SLOTB);
  WAIT_BAR(3);
  BLOAD(pA0,pA1,0); qkt(pA0,pA1,Kbase,qr,r32,hi);asm volatile("s_nop 15\n\ts_nop 7":"+v"(pA0),"+v"(pA1));CMASK(pA0,pA1,0);
  START(pA0,pA1);
  _Pragma("unroll") for(int r=0;r<16;++r)pA1[r]=__builtin_amdgcn_exp2f(pA1[r]);
  WAIT_BAR(0);
  DMA_K(3,0);DMA_V(1,SLOTB);
  ROT();
  kload8(kf,kp0+sl_cur);
  WAIT_BAR(2);
  s16x4 vlo[8],vhi[8]; u32x4 pw0,pw1,pw2,pw3;
  #define PKW(P,B) cvtpk_s(P[B],P[B+1])
  #define PAF(k) __builtin_bit_cast(bf16x8,pw##k)
  #define VFR(i) (bf16x8){vlo[i][0],vlo[i][1],vlo[i][2],vlo[i][3],vhi[i][0],vhi[i][1],vhi[i][2],vhi[i][3]}
  #define PIN(x) asm volatile("":"+v"(x))
  #define MX3(a,b,c) __builtin_fmaxf(__builtin_fmaxf((a),(b)),(c))
  #define GAPA(MF,A0,A1,A2,A3,W0,W1,PW) do{ MF; sacc+=A0; sacc+=A1; sacc+=A2; sacc+=A3; PIN(sacc); W0; W1; PIN(PW); SBAR(); }while(0)
  #define EX(v) __builtin_amdgcn_exp2f(v)
  #define GAPB(MF,X,B) do{ MF; X[B]=EX(X[B]); X[B+1]=EX(X[B+1]); X[B+2]=EX(X[B+2]); X[B+3]=EX(X[B+3]); PIN(X); SBAR(); }while(0)
  #define VRD(i) do{ vlo[i]=vtr(vp_+(((i)>>2)*4096+((i)&3)*1024)); vhi[i]=vtr(vp_+(((i)>>2)*4096+((i)&3)*1024+512)); }while(0)
  #define KRD(G,j) do{ if(G){ kload2(kf,kp0+sl_next,j); SBAR(); } }while(0)
  #define STEP(C0,C1,P0,P1,t,GK,GV,GL) do{ SBAR(); \
    const lds_cptr vp_=vp0+sl_prev; \
    BLOAD1(C0,t,0); VRD(0); SBAR(); float sacc=(P0[0]+P0[1]); \
    GAPA(C0=__builtin_amdgcn_mfma_f32_32x32x16_bf16(kf[0],qr[0],C0,0,0,0), P0[2],P0[3],P0[4],P0[5],     pw0[0]=PKW(P0,0), pw0[1]=PKW(P0,2), pw0); \
    BLOAD1(C1,t,1); VRD(4); SBAR(); GAPA(C1=__builtin_amdgcn_mfma_f32_32x32x16_bf16(kf[1],qr[0],C1,0,0,0), P0[6],P0[7],P0[8],P0[9],     pw0[2]=PKW(P0,4), pw0[3]=PKW(P0,6), pw0); \
    VRD(1); SBAR(); GAPA(C0=__builtin_amdgcn_mfma_f32_32x32x16_bf16(kf[2],qr[1],C0,0,0,0),   P0[10],P0[11],P0[12],P0[13], pw1[0]=PKW(P0,8), pw1[1]=PKW(P0,10), pw1); \
    VRD(5); SBAR(); GAPA(C1=__builtin_amdgcn_mfma_f32_32x32x16_bf16(kf[3],qr[1],C1,0,0,0),   P0[14],P0[15],P1[0],P1[1],   pw1[2]=PKW(P0,12),pw1[3]=PKW(P0,14), pw1); \
    VRD(2); SBAR(); GAPA(C0=__builtin_amdgcn_mfma_f32_32x32x16_bf16(kf[4],qr[2],C0,0,0,0),   P1[2],P1[3],P1[4],P1[5],     pw2[0]=PKW(P1,0), pw2[1]=PKW(P1,2), pw2); \
    VRD(6); SBAR(); GAPA(C1=__builtin_amdgcn_mfma_f32_32x32x16_bf16(kf[5],qr[2],C1,0,0,0),   P1[6],P1[7],P1[8],P1[9],     pw2[2]=PKW(P1,4), pw2[3]=PKW(P1,6), pw2); \
    VRD(3); SBAR(); GAPA(C0=__builtin_amdgcn_mfma_f32_32x32x16_bf16(kf[6],qr[3],C0,0,0,0),   P1[10],P1[11],P1[12],P1[13], pw3[0]=PKW(P1,8), pw3[1]=PKW(P1,10), pw3); \
    VRD(7); SBAR(); GAPA(C1=__builtin_amdgcn_mfma_f32_32x32x16_bf16(kf[7],qr[3],C1,0,0,0),   P1[14],P1[15],0.f,0.f,       pw3[2]=PKW(P1,12),pw3[3]=PKW(P1,14), pw3); \
    l_reg+=sacc; \
    if(GK){DMA_K((t)+3,sl_cur);} if(GV){DMA_V((t)+1,sl_next);} \
    CMASK(C0,C1,t); \
    { float a=MX3(C0[0],C0[1],C1[0]),b=MX3(C0[2],C0[3],C1[1]); a=MX3(a,C1[2],C1[3]); \
      _Pragma("unroll") for(int r=4;r<16;r+=4){a=MX3(a,C0[r],C0[r+1]);b=MX3(b,C0[r+2],C0[r+3]);a=MX3(a,C1[r],C1[r+1]);b=MX3(b,C1[r+2],C1[r+3]);} \
      float rm=__builtin_fmaxf(a,b); { auto rr=__builtin_amdgcn_permlane32_swap(__float_as_uint(rm),__float_as_uint(rm),false,false); rm=__builtin_fmaxf(__uint_as_float(rr[0]),__uint_as_float(rr[1])); } \
      resc=false; \
      if(__builtin_expect(__any(rm>(float)THRL),0)){ const float dl=__builtin_fmaxf(rm,0.f); mhat+=dl; \
        _Pragma("unroll") for(int r=0;r<16;++r){C0[r]-=dl;C1[r]-=dl;} \
        const float f=__builtin_amdgcn_exp2f(-dl); l_reg*=f; if(hi==0)wsf[r32]=f; resc=true; } } \
    SBAR(); \
    GAPB(o[0]=__builtin_amdgcn_mfma_f32_32x32x16_bf16(PAF(0),VFR(0),o[0],0,0,0), C0,0); \
    GAPB(o[1]=__builtin_amdgcn_mfma_f32_32x32x16_bf16(PAF(0),VFR(4),o[1],0,0,0), C0,4); \
    KRD(GL,0); GAPB(o[0]=__builtin_amdgcn_mfma_f32_32x32x16_bf16(PAF(1),VFR(1),o[0],0,0,0), C0,8); \
    KRD(GL,1); GAPB(o[1]=__builtin_amdgcn_mfma_f32_32x32x16_bf16(PAF(1),VFR(5),o[1],0,0,0), C0,12); \
    KRD(GL,2); GAPB(o[0]=__builtin_amdgcn_mfma_f32_32x32x16_bf16(PAF(2),VFR(2),o[0],0,0,0), C1,0); \
    KRD(GL,3); GAPB(o[1]=__builtin_amdgcn_mfma_f32_32x32x16_bf16(PAF(2),VFR(6),o[1],0,0,0), C1,4); \
    GAPB(o[0]=__builtin_amdgcn_mfma_f32_32x32x16_bf16(PAF(3),VFR(3),o[0],0,0,0), C1,8); \
    GAPB(o[1]=__builtin_amdgcn_mfma_f32_32x32x16_bf16(PAF(3),VFR(7),o[1],0,0,0), C1,12); \
    }while(0)
  int t=1;
  #undef CMASK
  #define CMASK(P0,P1,t) do{}while(0)
  for(;t+5<NT;t+=2){
    STEP(pB0,pB1,pA0,pA1,t,true,true,true);     WAIT_BAR(2); RESC(); ROT();
    STEP(pA0,pA1,pB0,pB1,t+1,true,true,true);   WAIT_BAR(2); RESC(); ROT();
  }
  #undef CMASK
  #define CMASK(P0,P1,t) do{int jb_=(t)-(NT-4); if(jb_>=0)cmask(P0,P1,jb_,qrel,hi);}while(0)
  #define ENDW(tt) do{ if((tt)+3<NT){WAIT_BAR(2);} else if((tt)+2<NT){WAIT_BAR(1);} else {WAIT_BAR(0);} }while(0)
  for(;t+1<NT;t+=2){
    STEP(pB0,pB1,pA0,pA1,t,(t+3<NT),(t+1<NT),(t+1<NT));       ENDW(t);   RESC(); ROT();
    STEP(pA0,pA1,pB0,pB1,t+1,(t+4<NT),(t+2<NT),(t+2<NT));     ENDW(t+1); RESC(); ROT();
  }
  STEP(pB0,pB1,pA0,pA1,NT-1,false,false,false); RESC();
  { float sacc=pB0[0]+pB0[1]; _Pragma("unroll") for(int r=2;r<16;++r)sacc+=pB0[r]; _Pragma("unroll") for(int r=0;r<16;++r)sacc+=pB1[r]; l_reg+=sacc;
    pw0=(u32x4){PKW(pB0,0),PKW(pB0,2),PKW(pB0,4),PKW(pB0,6)};pw1=(u32x4){PKW(pB0,8),PKW(pB0,10),PKW(pB0,12),PKW(pB0,14)};pw2=(u32x4){PKW(pB1,0),PKW(pB1,2),PKW(pB1,4),PKW(pB1,6)};pw3=(u32x4){PKW(pB1,8),PKW(pB1,10),PKW(pB1,12),PKW(pB1,14)};
    SBAR(); pv(o,vb0+sl_cur,PAF(0),PAF(1),PAF(2),PAF(3)); }
  #undef PKW
  #undef PAF
  #undef VFR
  #undef PIN
  #undef MX3
  #undef GAPA
  #undef GAPB
  #undef EX
  #undef VRD
  #undef KRD
  #undef STEP
  #undef ENDW
  {auto rr=__builtin_amdgcn_permlane32_swap(__float_as_uint(l_reg),__float_as_uint(l_reg),false,false);l_reg=__uint_as_float(rr[0])+__uint_as_float(rr[1]);}
  if(hi==0)wsf[32+r32]=l_reg;asm volatile("s_waitcnt lgkmcnt(0)":::"memory");
  float rli[16];
  #pragma unroll
  for(int r=0;r<16;++r)rli[r]=__builtin_amdgcn_rcpf(wsf[32+crow(r,hi)]);
  bf16*Ow=O+(rowbase+q0+wid*QBLK)*DM+h*D;
  { bf16*stg=(bf16*)(shm+LDS_OST)+wid*2048;
    #pragma unroll
    for(int r=0;r<16;++r){const int orow=crow(r,hi);
      #pragma unroll
      for(int d0=0;d0<2;++d0)stg[orow*64+d0*32+r32]=__float2bfloat16(o[d0][r]*rli[r]);}
    asm volatile("s_waitcnt lgkmcnt(0)":::"memory");
    #pragma unroll
    for(int i=0;i<4;++i){const int row=i*8+(lane>>3),ch=lane&7; const u32x4 v=*(const u32x4*)(stg+row*64+ch*8); ATTN_STORE16(Ow+(long)row*DM+ch*8,v);} }
  asm volatile("s_waitcnt lgkmcnt(0)\n\ts_barrier":::"memory");
  #undef BLOAD
  #undef BLOAD1
  #undef BSUB16
  #undef DMA_K
  #undef DMA_V
  #undef CMASK
  #undef START
  #undef RESC
  #undef ROT
}
constexpr int ATTN_LDS_BYTES=LDS_BYTES;
#undef SBAR
#undef WAIT_BAR
}

#define LAS __attribute__((address_space(3)))
typedef unsigned short bfu;
typedef float f32x4 __attribute__((ext_vector_type(4)));
typedef unsigned v4u __attribute__((ext_vector_type(4)));
typedef unsigned v2u __attribute__((ext_vector_type(2)));
typedef short bf16x8 __attribute__((ext_vector_type(8)));
constexpr int NB = 16, SEQ = 2048, DM = 1024, MTOK = NB * SEQ, FF = 2816, NLAYER = 2, DIN = 7184, NZ = 21 * 256;
constexpr size_t MiB = 1u << 20;
constexpr size_t WO_UP1 = 0, WO_DN1 = WO_UP1 + (size_t)5632 * 1024, WO_IN = WO_DN1 + (size_t)1024 * 2816, WO_GATE = WO_IN + (size_t)NZ * 1024, WO_LRU = WO_GATE + (size_t)2048 * 1024,
                 WO_ATT = WO_LRU + (size_t)1024 * 1024, WO_O = WO_ATT + (size_t)1024 * 1024, WO_UP2 = WO_O + (size_t)1024 * 1024, WO_DN2 = WO_UP2 + (size_t)5632 * 1024, WL_ELEMS = WO_DN2 + (size_t)1024 * 2816;
constexpr size_t WS_RSQ = 0, WS_W = 4 * MiB, WS_XB = 112 * MiB, WS_LOGF = 176 * MiB, WS_ZLX = 178 * MiB, WS_G = 242 * MiB, WS_Q = 306 * MiB, WS_K = 370 * MiB, WS_V = 434 * MiB, WS_END = 498 * MiB;
constexpr size_t WS_ACT = WS_ZLX; constexpr size_t WS_RSTD2 = 111 * MiB + 512 * 1024, WS_BAR = 111 * MiB + 768 * 1024, BAR_BYTES = 16384;
static_assert(WS_W + 2 * WL_ELEMS * 2 <= WS_RSTD2 && WS_RSTD2 + MTOK * 4 <= WS_XB && MTOK == pg8::RSQ_ROWS && WS_W + 2 * WL_ELEMS * 2 <= WS_XB && (size_t)MTOK * FF * 2 <= WS_K - WS_ZLX, "workspace map");
constexpr int LDS_BYTES = 147456;

__device__ __forceinline__ unsigned f2bf(float f) { unsigned u = __builtin_bit_cast(unsigned, f); return (u + 0x7fffu + ((u >> 16) & 1u)) >> 16; }
__device__ __forceinline__ unsigned pk2(float lo, float hi) { return f2bf(lo) | (f2bf(hi) << 16); }
__device__ __forceinline__ float bf2f(unsigned short h) { return __uint_as_float((unsigned)h << 16); }
#define LDS_WAIT() asm volatile("s_waitcnt lgkmcnt(0)" ::: "memory")

__device__ __forceinline__ void tr_item64(const float* W, int N, int K, int k0, int srcA, int nvA, int srcB, int nvB, const float* g, bfu* WT, int dst_row0, LAS float* scr, int lane) {
    const int h = (lane >> 3) & 1, c4 = 4 * (lane & 7); const bool ok = c4 < (h ? nvB : nvA);
    const float* wp = W + (size_t)(k0 + (lane >> 4)) * N + (h ? srcB : srcA) + c4; const float* gp = g ? g + k0 + (lane >> 4) : nullptr;
    LAS float* sp = scr + (lane >> 4) * 65 + 32 * h + c4;
#pragma unroll 8
    for (int i = 0; i < 16; ++i) { f32x4 v = {0.f, 0.f, 0.f, 0.f}; if (ok) v = *(const f32x4*)(wp + (size_t)(4 * i) * N); if (gp) v = v * gp[4 * i];
        sp[(4 * i) * 65 + 0] = v[0]; sp[(4 * i) * 65 + 1] = v[1]; sp[(4 * i) * 65 + 2] = v[2]; sp[(4 * i) * 65 + 3] = v[3]; }
    LDS_WAIT(); asm volatile("" ::: "memory");
    const int c = lane & 7;
#pragma unroll
    for (int q = 0; q < 8; ++q) { const int n = 8 * q + (lane >> 3); const LAS float* s = scr + (8 * c) * 65 + n;
        v4u o; o.x = pk2(s[0 * 65], s[1 * 65]); o.y = pk2(s[2 * 65], s[3 * 65]); o.z = pk2(s[4 * 65], s[5 * 65]); o.w = pk2(s[6 * 65], s[7 * 65]);
        *(v4u*)(WT + (size_t)(dst_row0 + n) * K + k0 + 8 * c) = o; }
    LDS_WAIT(); asm volatile("" ::: "memory");
}
__device__ __forceinline__ void win_src(int r, int& src, int& nv) { const int pn = r >> 3, r8 = r & 7; nv = 32;
    if (pn < 8) src = 256 * pn + 32 * r8;
    else if (pn < 16) src = 2048 + 256 * (pn - 8) + 64 * (r8 & 3) + 32 * (r8 >> 2);
    else if (pn < 20) src = 4096 + 256 * (pn - 16) + 32 * r8;
    else { src = 5120; nv = (r8 == 0) ? 16 : 0; } }
__device__ __forceinline__ int up_src(int r) { const int pn = r >> 3, r8 = r & 7; return (r8 >> 2) * 2816 + 128 * pn + 32 * (r8 & 3); }
struct Args { const float* in[23]; float* out; unsigned char* ws; };

typedef const __attribute__((address_space(4))) Args* kargs_t;
__device__ __forceinline__ void prologue(kargs_t a, LAS unsigned char* lds, int gw, int NGW, int wave, int lane) {
    LAS float* scr = (LAS float*)(lds + wave * 16640);
    constexpr int I_UP = 88 * 16, I_DN = 16 * 44, I_IN = 84 * 16, I_GT = 32 * 16, I_SQ = 16 * 16;
    constexpr int I_LAYER = 2 * I_UP + 2 * I_DN + I_IN + I_GT + 3 * I_SQ;
    for (int it = gw; it < NLAYER * I_LAYER; it += NGW) {
        const int l = it / I_LAYER; int r = it - l * I_LAYER;
        bfu* WL = (bfu*)(a->ws + WS_W) + (size_t)l * WL_ELEMS;
        if (r < 2 * I_UP) { const int second = r >= I_UP; if (second) r -= I_UP;
            const int kb = r / 88, nb = r - kb * 88;
            tr_item64(a->in[second ? 21 : 2] + (size_t)l * 1024 * 5632, 5632, 1024, kb * 64, up_src(2 * nb), 32, up_src(2 * nb + 1), 32, a->in[second ? 20 : 1] + l * 1024, WL + (second ? WO_UP2 : WO_UP1), nb * 64, scr, lane); continue; }
        r -= 2 * I_UP;
        if (r < 2 * I_DN) { const int second = r >= I_DN; if (second) r -= I_DN;
            const int kb = r >> 4, nb = r & 15;
            tr_item64(a->in[second ? 22 : 3] + (size_t)l * 2816 * 1024, 1024, 2816, kb * 64, nb * 64, 32, nb * 64 + 32, 32, nullptr, WL + (second ? WO_DN2 : WO_DN1), nb * 64, scr, lane); continue; }
        r -= 2 * I_DN;
        if (r < I_IN) { const int kb = r / 84, nb = r - kb * 84; int sA, nA, sB, nB; win_src(2 * nb, sA, nA); win_src(2 * nb + 1, sB, nB);
            tr_item64(a->in[5] + (size_t)l * 1024 * DIN, DIN, 1024, kb * 64, sA, nA, sB, nB, a->in[4] + l * 1024, WL + WO_IN, nb * 64, scr, lane); continue; }
        r -= I_IN;
        if (r < I_GT) { const int kb = r >> 5, nb = r & 31;
            const int gsrc = 5136 + ((nb >> 1) & 1) * 1024 + 128 * (nb >> 2) + 64 * (nb & 1);
            tr_item64(a->in[5] + (size_t)l * 1024 * DIN, DIN, 1024, kb * 64, gsrc, 32, gsrc + 32, 32, a->in[4] + l * 1024, WL + WO_GATE, nb * 64, scr, lane); continue; }
        r -= I_GT;
        { const int w = r / I_SQ; r -= w * I_SQ; const int kb = r >> 4, nb = r & 15;
            tr_item64(a->in[17 + w] + (size_t)l * 1024 * 1024, 1024, 1024, kb * 64, nb * 64, 32, nb * 64 + 32, 32, nullptr, WL + (w == 0 ? WO_LRU : w == 1 ? WO_ATT : WO_O), nb * 64, scr, lane); }
    }
    float* rsq = (float*)(a->ws + WS_RSQ); bfu* xb = (bfu*)(a->ws + WS_XB);
    for (int m0 = 2 * gw; m0 < MTOK; m0 += 2 * NGW) {
        f32x4 v[2][4]; float sq[2];
#pragma unroll
        for (int rr = 0; rr < 2; ++rr) { const f32x4* xr = (const f32x4*)(a->in[0] + (size_t)(m0 + rr) * DM) + lane;
#pragma unroll
            for (int j = 0; j < 4; ++j) v[rr][j] = xr[64 * j]; }
#pragma unroll
        for (int rr = 0; rr < 2; ++rr) { float s = 0.f;
#pragma unroll
            for (int j = 0; j < 4; ++j) s += (v[rr][j][0] * v[rr][j][0] + v[rr][j][1] * v[rr][j][1]) + (v[rr][j][2] * v[rr][j][2] + v[rr][j][3] * v[rr][j][3]);
#pragma unroll
            for (int o = 1; o < 64; o <<= 1) s += pg8::bperm(lane ^ o, s);
            sq[rr] = s; }
#pragma unroll
        for (int rr = 0; rr < 2; ++rr) { const int m = m0 + rr;
            if (lane < 16) rsq[(size_t)m * 16 + lane] = lane == 0 ? sq[rr] : 0.f;
            v2u* o8 = (v2u*)(xb + (size_t)m * DM) + lane;
#pragma unroll
            for (int j = 0; j < 4; ++j) { v2u w; w.x = pk2(v[rr][j][0], v[rr][j][1]); w.y = pk2(v[rr][j][2], v[rr][j][3]); o8[64 * j] = w; } } }
}

constexpr int SC_XA = 0, SC_WT = 17408, SC_XF = 52224, SC_AA = 68608, SC_UU = 84992, SC_SEG = 101376, SC_CAR = 105472, SC_CW = 105984, SC_CH = 108544, SC_GT = 109312, SC_YT = 118528, SC_END = 127744;
__device__ __forceinline__ void scan_item(LAS unsigned char* lds, int b, int n, int hf, const bfu* ZLX, bfu* G, const float* conv_w, const float* conv_b,
                                          const float* w_a, const float* b_a, const float* w_x, const float* b_x, const float* lam, int tid) {
    LAS bfu* XA = (LAS bfu*)(lds + SC_XA); LAS bfu* WT = (LAS bfu*)(lds + SC_WT); LAS float* XF = (LAS float*)(lds + SC_XF); LAS float* AA = (LAS float*)(lds + SC_AA); LAS float* UU = (LAS float*)(lds + SC_UU);
    LAS float* SEG = (LAS float*)(lds + SC_SEG); LAS float* CAR = (LAS float*)(lds + SC_CAR); LAS float* CW = (LAS float*)(lds + SC_CW); LAS float* CH = (LAS float*)(lds + SC_CH);
    LAS bfu* GT = (LAS bfu*)(lds + SC_GT); LAS bfu* YT = (LAS bfu*)(lds + SC_YT);
    const int lane = tid & 63, wave = tid >> 6;
    for (int idx = tid; idx < 128 * 64; idx += 512) { const int c = idx >> 6, dl = idx & 63; const size_t src = ((size_t)n * 128 + c) * 128 + 64 * hf + dl;
        const unsigned pw_ = pg8::cvt_pk_bf16(w_a[src], w_x[src]); WT[dl * 136 + c] = (bfu)(pw_ & 0xffffu); WT[(64 + dl) * 136 + c] = (bfu)(pw_ >> 16); }
    if (tid < 128) { CW[tid] = conv_w[128 * n + tid]; CW[128 + tid] = conv_w[1024 + 128 * n + tid]; CW[256 + tid] = conv_w[2048 + 128 * n + tid]; CW[384 + tid] = conv_w[3072 + 128 * n + tid]; CW[512 + tid] = conv_b[128 * n + tid]; }
    if (tid < 64) { const int d = 128 * n + 64 * hf + tid; CH[tid] = b_a[d]; CH[64 + tid] = b_x[d]; CH[128 + tid] = 8.0f * log1pf(expf(-lam[d])); CAR[tid] = 0.f; }
    __syncthreads();
    const int cg4 = tid & 31, tg = tid >> 5;
    f32x4 cw[4], cb;
#pragma unroll
    for (int k = 0; k < 4; ++k) cw[k] = *(const LAS f32x4*)(CW + 128 * k + 4 * cg4);
    cb = *(const LAS f32x4*)(CW + 512 + 4 * cg4);
    const int tt = wave >> 1, cts = 2 * (wave & 1), l15 = lane & 15, lq = lane >> 4;
    const int sc = tid & 63, sg = tid >> 6;
    bf16x8 wfr[2][2][4];
#pragma unroll
    for (int mt = 0; mt < 2; ++mt)
#pragma unroll
        for (int ci = 0; ci < 2; ++ci)
#pragma unroll
            for (int ks = 0; ks < 4; ++ks) wfr[mt][ci][ks] = *(const LAS bf16x8*)(WT + (64 * mt + 16 * (cts + ci) + l15) * 136 + 32 * ks + 8 * lq);
    const size_t rowb = (size_t)b * SEQ;
    const bfu* zsrc = ZLX + rowb * DM + 128 * n + 4 * cg4;
    v2u xw[7];
#pragma unroll
    for (int i = 0; i < 7; ++i) { const int r = 4 * tg - 3 + i; xw[i] = (v2u){0u, 0u}; if (r >= 0) xw[i] = *(const v2u*)(zsrc + (size_t)r * DM); }
    for (int ch = 0; ch < SEQ / 64; ++ch) {
        const int t0 = ch * 64;
        bfu* gio = G + (rowb + t0 + (tid >> 3)) * DM + 128 * n + 64 * hf + 8 * (tid & 7);
        const v4u gvec = *(const v4u*)gio;
        { f32x4 xr[7];
#pragma unroll
            for (int i = 0; i < 7; ++i) { const v2u w = xw[i];
                xr[i][0] = __uint_as_float(w.x << 16); xr[i][1] = __uint_as_float(w.x & 0xffff0000u); xr[i][2] = __uint_as_float(w.y << 16); xr[i][3] = __uint_as_float(w.y & 0xffff0000u); }
            if (ch + 1 < SEQ / 64) {
#pragma unroll
                for (int i = 0; i < 7; ++i) xw[i] = *(const v2u*)(zsrc + (size_t)(t0 + 64 + 4 * tg - 3 + i) * DM); }
#pragma unroll
            for (int j = 0; j < 4; ++j) { f32x4 y = cb + cw[0] * xr[j] + cw[1] * xr[j + 1] + cw[2] * xr[j + 2] + cw[3] * xr[j + 3];
                v2u w; w.x = pg8::cvt_pk_bf16(y[0], y[1]); w.y = pg8::cvt_pk_bf16(y[2], y[3]); *(LAS v2u*)(XA + (4 * tg + j) * 136 + 4 * cg4) = w;
                if ((cg4 >> 4) == hf) *(LAS f32x4*)(XF + (4 * tg + j) * 64 + 4 * (cg4 & 15)) = y; } }
        __syncthreads();
        *(LAS v4u*)(GT + (tid >> 3) * 64 + 8 * (tid & 7)) = gvec;
        if (ch > 0) *(v4u*)(gio - (size_t)64 * DM) = *(const LAS v4u*)(YT + (tid >> 3) * 64 + 8 * (tid & 7));
        { f32x4 acc[2][2];
#pragma unroll
            for (int mt = 0; mt < 2; ++mt)
#pragma unroll
                for (int ci = 0; ci < 2; ++ci) acc[mt][ci] = (f32x4){0.f, 0.f, 0.f, 0.f};
#pragma unroll
            for (int ks = 0; ks < 4; ++ks) { const bf16x8 af = *(const LAS bf16x8*)(XA + (16 * tt + l15) * 136 + 32 * ks + 8 * lq);
#pragma unroll
                for (int mt = 0; mt < 2; ++mt)
#pragma unroll
                    for (int ci = 0; ci < 2; ++ci) acc[mt][ci] = __builtin_amdgcn_mfma_f32_16x16x32_bf16(af, wfr[mt][ci][ks], acc[mt][ci], 0, 0, 0); }
#pragma unroll
            for (int ci = 0; ci < 2; ++ci) { const int d = 16 * (cts + ci) + l15; const float ba = CH[d], bx = CH[64 + d], sp8 = CH[128 + d];
#pragma unroll
                for (int j = 0; j < 4; ++j) { const int tok = 16 * tt + 4 * lq + j;
                    const float r = pg8::sigm(acc[0][ci][j] + ba), ig = pg8::sigm(acc[1][ci][j] + bx);
                    const float la = -sp8 * r, av = __builtin_amdgcn_exp2f(pg8::kLog2e * la);
                    const float om = __builtin_fmaf(-av, av, 1.0f);
                    AA[tok * 64 + d] = av; UU[tok * 64 + d] = __builtin_sqrtf(om) * ig * XF[tok * 64 + d]; } } }
        __syncthreads();
        { float av[8], uv[8];
#pragma unroll
            for (int k = 0; k < 8; ++k) { av[k] = AA[(8 * sg + k) * 64 + sc]; uv[k] = UU[(8 * sg + k) * 64 + sc]; }
            float P = 1.f, H = 0.f;
#pragma unroll
            for (int k = 0; k < 8; ++k) { H = av[k] * H + uv[k]; P *= av[k]; }
            SEG[(sg * 64 + sc) * 2] = P; SEG[(sg * 64 + sc) * 2 + 1] = H;
            __syncthreads();
            float h = CAR[(ch & 1) * 64 + sc];
            { float sp_[7], sh_[7];
#pragma unroll
              for (int s = 0; s < 7; ++s) { sp_[s] = SEG[(s * 64 + sc) * 2]; sh_[s] = SEG[(s * 64 + sc) * 2 + 1]; }
#pragma unroll
              for (int s = 0; s < 7; ++s) h = (s < sg) ? sp_[s] * h + sh_[s] : h; }
#pragma unroll
            for (int k = 0; k < 8; ++k) { h = av[k] * h + uv[k]; YT[(8 * sg + k) * 64 + sc] = (bfu)(pg8::cvt_pk_bf16(bf2f(GT[(8 * sg + k) * 64 + sc]) * h, 0.f) & 0xffffu); }
            if (sg == 7) CAR[((ch + 1) & 1) * 64 + sc] = h; }
    }
    __syncthreads();
    *(v4u*)(G + (rowb + SEQ - 64 + (tid >> 3)) * DM + 128 * n + 64 * hf + 8 * (tid & 7)) = *(const LAS v4u*)(YT + (tid >> 3) * 64 + 8 * (tid & 7));
    __syncthreads();
}

__device__ __forceinline__ void forget_phase(const bfu* xb, const bfu* wf  , const float* rowsq, const float* bforget, float* logf, float* rstd2, int bx, int G, int tid) {
    const int lane = tid & 63, wave = tid >> 6, l15 = lane & 15, lq = lane >> 4;
    for (int blk = bx * 8 + wave; blk < MTOK / 16; blk += G * 8) {
        const int row0 = blk * 16;
        const bfu* ap = xb + (size_t)(row0 + l15) * DM + 8 * lq; const bfu* bp = wf + (size_t)l15 * DM + 8 * lq;
        f32x4 acc = {0.f, 0.f, 0.f, 0.f};
#pragma unroll 8
        for (int ks = 0; ks < 32; ++ks) { const bf16x8 af = *(const bf16x8*)(ap + 32 * ks), bfv = *(const bf16x8*)(bp + 32 * ks); acc = __builtin_amdgcn_mfma_f32_16x16x32_bf16(af, bfv, acc, 0, 0, 0); }
        const float bf = bforget[l15];
#pragma unroll
        for (int j = 0; j < 4; ++j) { const int row = row0 + 4 * lq + j; const f32x4* pp = (const f32x4*)(rowsq + (size_t)row * 16);
            const f32x4 p0 = pp[0], p1 = pp[1], p2 = pp[2], p3 = pp[3];
            const float ssum = ((p0[0] + p0[1]) + (p0[2] + p0[3])) + ((p1[0] + p1[1]) + (p1[2] + p1[3])) + ((p2[0] + p2[1]) + (p2[2] + p2[3])) + ((p3[0] + p3[1]) + (p3[2] + p3[3]));
            const float rs = __builtin_amdgcn_rsqf(ssum * (1.0f / 1024.0f) + 1e-6f);
            const float x = acc[j] * rs + bf;
            logf[(size_t)row * 16 + l15] = fminf(x, 0.f) - log1pf(__expf(-fabsf(x)));
            if (l15 == 0) rstd2[row] = rs; }
    }
}
constexpr int ATT_TBL_BYTES = (SEQ + 64) * 4, ATT_SCR_OFF = attn_body::LDS_NB + 2 * ATT_TBL_BYTES;
__device__ __forceinline__ void bias_table(LAS unsigned char* lds, const float* logf, const float* gq, const float* gk, int b, int h, int tid, int tbl) {
    LAS float* nb = (LAS float*)(lds + attn_body::LDS_NB + tbl * ATT_TBL_BYTES); LAS float* wsum = (LAS float*)(lds + ATT_SCR_OFF);
    const int lane = tid & 63, wave = tid >> 6;
    const float* p = logf + ((size_t)b * SEQ + 4 * tid) * 16 + h;
    float v0 = p[0], v1 = p[16], v2 = p[32], v3 = p[48];
    v1 += v0; v2 += v1; v3 += v2;
    float s = v3;
#pragma unroll
    for (int o = 1; o < 64; o <<= 1) { const float t = pg8::bperm(lane - o, s); if (lane >= o) s += t; }
    if (lane == 63) wsum[wave] = s;
    __syncthreads();
    float off = s - v3;
    for (int w = 0; w < wave; ++w) off += wsum[w];
    const float k = -pg8::kLog2e;
    *(LAS f32x4*)(nb + 4 * tid) = (f32x4){(off + v0) * k, (off + v1) * k, (off + v2) * k, (off + v3) * k};
    if (tid < 64) { nb[SEQ + tid] = 0.f;
        float mq = fabsf(gq[tid]), mk = fabsf(gk[tid]);
#pragma unroll
        for (int o = 1; o < 64; o <<= 1) { mq = fmaxf(mq, pg8::bperm(lane ^ o, mq)); mk = fmaxf(mk, pg8::bperm(lane ^ o, mk)); }
        if (tid == 0) wsum[8] = attn_body::C2 * 64.0f * mq * mk; }
    __syncthreads();
}

#define GRID_SYNC_CG() do { asm volatile("s_waitcnt vmcnt(0) lgkmcnt(0)" ::: "memory"); grid.sync(); } while (0)
#define GRID_SYNC() do { kargs_t apb_ = (kargs_t)__builtin_amdgcn_kernarg_segment_ptr(); asm volatile("" : "+s"(apb_)); XcdBarrier xb_; xb_.bar = (unsigned*)(apb_->ws + WS_BAR); xb_.x = xb_xcc_id(); xb_.st = (volatile LAS unsigned*)(lds + (LDS_BYTES - 64)); \
    TID_NOW(tb_); xcd_barrier(xb_, tb_ == 0); } while (0)
#define PHASE_ARGS() kargs_t ap = (kargs_t)__builtin_amdgcn_kernarg_segment_ptr(); asm volatile("" : "+s"(ap)); unsigned char* const ws = ap->ws; (void)ws

#define RLX_AGENT __ATOMIC_RELAXED, __HIP_MEMORY_SCOPE_AGENT
#define XB_TMO      128
#define XB_XCNT(j)  (256  + 64 * (j))
#define XB_XSUB(j)  (1280 + 64 * (j))
#define XB_XGEN(j)  (2304 + 64 * (j))
#define XB_TOP      3328
#define XB_TOPGEN   3392
#define XCD_BAR_WORDS 3456
#define XB_SPIN_CAP (1u << 18)

__device__ __forceinline__ unsigned xb_ld(unsigned* p)              { return __hip_atomic_load(p, __ATOMIC_RELAXED, __HIP_MEMORY_SCOPE_AGENT); }
__device__ __forceinline__ unsigned xb_add(unsigned* p, unsigned v) { return __hip_atomic_fetch_add(p, v, __ATOMIC_RELAXED, __HIP_MEMORY_SCOPE_AGENT); }
__device__ __forceinline__ unsigned xb_xcc_id() { return (unsigned)__builtin_amdgcn_s_getreg((3 << 11) | 20) & 0xFu; }
#define XB_SPIN(cond, bar) do { unsigned _sp = 0; while (cond) { __builtin_amdgcn_s_sleep(1); \
    if ((++_sp & 255u) == 0u) { if (xb_ld(&(bar)[XB_TMO])) break; if (_sp > XB_SPIN_CAP) { atomicAdd(&(bar)[XB_TMO], 1u); break; } } } } while (0)

struct XcdBarrier {
    unsigned* bar; unsigned x;
    volatile LAS unsigned* st;
};

__device__ __forceinline__ XcdBarrier xcd_barrier_post(unsigned* bar, volatile LAS unsigned* st, bool leader) {
    XcdBarrier b; b.bar = bar; b.x = xb_xcc_id(); b.st = st;
    if (leader) (void)xb_add(&bar[XB_XCNT(b.x)], 1u);
    return b;
}
__device__ __forceinline__ void xcd_barrier_complete(unsigned* bar, unsigned x, unsigned& nloc, unsigned& nx) {
    const unsigned G = gridDim.x * gridDim.y * gridDim.z;
    unsigned sum, cnt, mine, sp = 0u;
    for (;;) {
        sum = 0u; cnt = 0u; mine = 0u;
#pragma unroll
        for (unsigned j = 0; j < 16; ++j) { const unsigned c = xb_ld(&bar[XB_XCNT(j)]); sum += c; cnt += (c > 0u) ? 1u : 0u; mine = (j == x) ? c : mine; }
        if (sum == G) break;
        __builtin_amdgcn_s_sleep(1);
        if ((++sp & 255u) == 0u) { if (xb_ld(&bar[XB_TMO])) break; if (sp > XB_SPIN_CAP) { atomicAdd(&bar[XB_TMO], 1u); break; } }
    }
    nloc = mine > 0u ? mine : 1u; nx = cnt > 0u ? cnt : 1u;
}

__device__ __forceinline__ void xcd_barrier(const XcdBarrier& b, bool leader) {
    asm volatile("s_waitcnt vmcnt(0)" ::: "memory");
    __syncthreads();
    if (leader) {
        unsigned* bar = b.bar;
        __builtin_amdgcn_s_waitcnt(0);
        unsigned nloc = b.st[0], nx = b.st[1];
        if (nloc == 0u) { xcd_barrier_complete(bar, b.x, nloc, nx); b.st[0] = nloc; b.st[1] = nx; }
        const unsigned old = xb_add(&bar[XB_XSUB(b.x)], 1u);
        const unsigned gen = old / nloc;
        if (old + 1u == (gen + 1u) * nloc) {
            __builtin_amdgcn_fence(__ATOMIC_RELEASE, "agent");
            asm volatile("s_waitcnt vmcnt(0)" ::: "memory");
            const unsigned og = xb_add(&bar[XB_TOP], 1u);
            const unsigned tg = og / nx;
            if (og + 1u == (tg + 1u) * nx) xb_add(&bar[XB_TOPGEN], 1u);
            else XB_SPIN(xb_ld(&bar[XB_TOPGEN]) == tg, bar);
            __builtin_amdgcn_fence(__ATOMIC_ACQUIRE, "agent");
            xb_add(&bar[XB_XGEN(b.x)], 1u);
            asm volatile("s_waitcnt vmcnt(0)" ::: "memory");
        } else {
            XB_SPIN(xb_ld(&bar[XB_XGEN(b.x)]) == gen, bar);
            __builtin_amdgcn_fence(__ATOMIC_ACQUIRE, "agent");
            asm volatile("s_waitcnt vmcnt(0)" ::: "memory");
        }
    }
    __syncthreads();
}

#ifdef DBG_STOP
#define DBG_AT(k, buf) do { if (DBG_STOP == (k) && l == 0) { GRID_SYNC(); PHASE_ARGS(); const bfu* src_ = (const bfu*)(ws + (buf)); float* o_ = ap->out; \
    TID_NOW(tid_); for (size_t i_ = (size_t)bx * 512 + tid_; i_ < (size_t)MTOK * DM; i_ += (size_t)G * 512) o_[i_] = bf2f(src_[i_]); return; } } while (0)
#define DBG_ATF(k, buf) do { if (DBG_STOP == (k) && l == 0) { GRID_SYNC(); PHASE_ARGS(); const float* src_ = (const float*)(ws + (buf)); float* o_ = ap->out; \
    TID_NOW(tid_); for (size_t i_ = (size_t)bx * 512 + tid_; i_ < (size_t)MTOK * DM; i_ += (size_t)G * 512) o_[i_] = src_[i_ >> 10]; return; } } while (0)
#else
#define DBG_ATF(k, buf) do {} while (0)
#define DBG_AT(k, buf) do {} while (0)
#endif
__global__ void __launch_bounds__(512, 2) fwd_megakernel(Args a_unused) {
    extern __shared__ __attribute__((aligned(16))) unsigned char lds_raw[];
    cg::grid_group grid = cg::this_grid();
    LAS unsigned char* lds = (LAS unsigned char*)lds_raw;
    const int wave_s = __builtin_amdgcn_readfirstlane((int)threadIdx.x >> 6);
#define TID_NOW(v) int v; asm volatile("v_mbcnt_lo_u32_b32 %0, -1, 0\n\tv_mbcnt_hi_u32_b32 %0, -1, %0" : "=v"(v)); v += wave_s * 64
    const int G = gridDim.x, bx = blockIdx.x;

    { TID_NOW(t0_); if (t0_ < 2) ((volatile LAS unsigned*)(lds + (LDS_BYTES - 64)))[t0_] = 0u; __syncthreads();
      kargs_t apb_ = (kargs_t)__builtin_amdgcn_kernarg_segment_ptr(); (void)xcd_barrier_post((unsigned*)(apb_->ws + WS_BAR), (volatile LAS unsigned*)(lds + (LDS_BYTES - 64)), t0_ == 0); }
    { PHASE_ARGS(); TID_NOW(tl); prologue(ap, lds, bx * 8 + (tl >> 6), G * 8, tl >> 6, tl & 63); }
    if (G == 0x7fffffff) grid.sync();
    GRID_SYNC();

    for (int ph = 0; ph < 9 * NLAYER; ++ph) { const int l = ph / 9, sub = ph - 9 * l;
        if (sub == 0) {
        { PHASE_ARGS(); TID_NOW(tl); const bfu* WL = (const bfu*)(ws + WS_W) + (size_t)l * WL_ELEMS; const bfu* xb = (const bfu*)(ws + WS_XB);
          pg8::Gemm g{xb, xb, xb, xb, WL + WO_UP1, WL + WO_UP1, WL + WO_UP1, WL + WO_UP1, 1024}; pg8::StaticOrder S; S.init(MTOK, 5632, G, bx, 1);
          pg8::EpiUp E{(bfu*)(ws + WS_ACT), (const float*)(ws + WS_RSQ) + (size_t)((3 * l) & 1) * 16 * MTOK};
          pg8::gemm_phase<pg8::EpiUp, pg8::StaticOrder, true, true>(lds, g, S, E, tl); }
        } else if (sub == 1) {
        { PHASE_ARGS(); TID_NOW(tl); const bfu* WL = (const bfu*)(ws + WS_W) + (size_t)l * WL_ELEMS; const bfu* act = (const bfu*)(ws + WS_ACT);
          pg8::Gemm g{act, act, act, act, WL + WO_DN1, WL + WO_DN1, WL + WO_DN1, WL + WO_DN1, 2816}; pg8::StaticOrder S; S.init(MTOK, 1024, G, bx, 1);
          pg8::EpiRes E{l == 0 ? ap->in[0] : (const float*)ap->out, ap->out, (bfu*)(ws + WS_XB), (float*)(ws + WS_RSQ) + (size_t)((3 * l + 1) & 1) * 16 * MTOK, 0.5f};
          pg8::gemm_phase<pg8::EpiRes, pg8::StaticOrder, true, true>(lds, g, S, E, tl); }
        } else if (sub == 2) {
        { PHASE_ARGS(); TID_NOW(tl); const bfu* WL = (const bfu*)(ws + WS_W) + (size_t)l * WL_ELEMS; const bfu* xb = (const bfu*)(ws + WS_XB);
          pg8::Gemm g{xb, xb, xb, xb, WL + WO_IN, WL + WO_IN, WL + WO_IN, WL + WO_IN, 1024}; pg8::StaticOrder S; S.init(MTOK, NZ - 256, G, bx, 1);
          pg8::EpiZ E{(bfu*)(ws + WS_ZLX), (bfu*)(ws + WS_G), (bfu*)(ws + WS_Q), (bfu*)(ws + WS_K), (bfu*)(ws + WS_V), (float*)(ws + WS_LOGF), (const float*)(ws + WS_RSQ) + (size_t)((3 * l + 1) & 1) * 16 * MTOK,
                      ap->in[14] + l * 64, ap->in[15] + l * 64, ap->in[16] + l * 16, attn_body::C2, (float*)(ws + WS_RSTD2)};
          pg8::gemm_phase<pg8::EpiZ, pg8::StaticOrder, true, true>(lds, g, S, E, tl); }
        } else if (sub == 3) {
        { PHASE_ARGS(); TID_NOW(tl); const bfu* WL = (const bfu*)(ws + WS_W) + (size_t)l * WL_ELEMS;
          forget_phase((const bfu*)(ws + WS_XB), WL + WO_IN + (size_t)5120 * 1024, (const float*)(ws + WS_RSQ) + (size_t)((3 * l + 1) & 1) * 16 * MTOK, ap->in[16] + l * 16, (float*)(ws + WS_LOGF), (float*)(ws + WS_RSTD2), bx, G, tl); }
        } else if (sub == 4) {
        { PHASE_ARGS();
          for (int grp = bx; grp < NB * 16; grp += G) {
            TID_NOW(tl);
            const int b = grp >> 4, p = (grp & 15) >> 1, side = grp & 1;
            const float* bfp = ap->in[16] + l * 16;
            int hA = 0, hB = 0;
            for (int h = 0; h < 16; ++h) { const float v = bfp[h]; int rk = 0;
                for (int j = 0; j < 16; ++j) { const float w = bfp[j]; rk += (w > v || (w == v && j < h)) ? 1 : 0; }
                if (rk == p) hA = h; if (rk == 15 - p) hB = h; }
            bias_table(lds, (const float*)(ws + WS_LOGF), ap->in[14] + l * 64, ap->in[15] + l * 64, b, hA, tl, 0);
            bias_table(lds, (const float*)(ws + WS_LOGF), ap->in[14] + l * 64, ap->in[15] + l * 64, b, hB, tl, 1);
            const float qkmax = __builtin_bit_cast(float, __builtin_amdgcn_readfirstlane(__builtin_bit_cast(int, ((const LAS float*)(lds + ATT_SCR_OFF))[8])));
            unsigned long long tspack = 0ull; unsigned mine = 0u; int load0 = 0, load1 = 0;
            for (int u = 0; u < 16; ++u) { const int hs = u >> 3, qb = 7 - (u & 7);
                const LAS float* nbL = (const LAS float*)(lds + attn_body::LDS_NB + hs * ATT_TBL_BYTES);
                const float lim = __builtin_bit_cast(float, __builtin_amdgcn_readfirstlane(__builtin_bit_cast(int, nbL[256 * qb]))) - (2.0f * qkmax + 40.0f);
                int ts = 0;
                while (ts + 2 <= 4 * qb && __builtin_bit_cast(float, __builtin_amdgcn_readfirstlane(__builtin_bit_cast(int, nbL[64 * (ts + 1) + 63]))) < lim) ts += 2;
                const int cost = (4 * qb + 4 - ts) + 4;
                const int owner = (load0 <= load1) ? 0 : 1; if (owner == 0) load0 += cost; else load1 += cost;
                if (owner == side) mine |= 1u << u;
                tspack |= (unsigned long long)(ts >> 1) << (4 * u); }
            for (int u = 0; u < 16; ++u) { if (!((mine >> u) & 1u)) continue;
                const int hs = u >> 3, qb = 7 - (u & 7), ts = (int)((tspack >> (4 * u)) & 15ull) * 2;
                attn_body::attn_unit<64>(b, hs ? hB : hA, qb, (const attn_body::bf16*)(ws + WS_Q), (const attn_body::bf16*)(ws + WS_K), (const attn_body::bf16*)(ws + WS_V), (attn_body::bf16*)(ws + WS_Q), (char*)lds_raw, tl, ts, hs * ATT_TBL_BYTES); }
            __syncthreads();
          }
        }
        { PHASE_ARGS();
          for (int it = bx; it < NB * 16; it += G) { TID_NOW(tl);
            scan_item(lds, it >> 4, (it >> 1) & 7, it & 1, (const bfu*)(ws + WS_ZLX), (bfu*)(ws + WS_G), ap->in[7] + (size_t)l * 4096, ap->in[8] + l * 1024, ap->in[9] + (size_t)l * 131072, ap->in[10] + l * 1024,
                      ap->in[11] + (size_t)l * 131072, ap->in[12] + l * 1024, ap->in[13] + l * 1024, tl); } }
        } else if (sub == 5) {
        { PHASE_ARGS(); TID_NOW(tl); const bfu* WL = (const bfu*)(ws + WS_W) + (size_t)l * WL_ELEMS; const bfu* xb = (const bfu*)(ws + WS_XB);
          pg8::Gemm g{(const bfu*)(ws + WS_G), (const bfu*)(ws + WS_Q), xb, xb, WL + WO_LRU, WL + WO_ATT, WL + WO_GATE, WL + WO_GATE, 1024}; pg8::StaticOrder S; S.init(MTOK, 1024, G, bx, 4, 1);
          pg8::EpiMerge E{(bfu*)(ws + WS_K), (bfu*)(ws + WS_V), (bfu*)(ws + WS_ZLX), (const float*)(ws + WS_RSTD2), ap->in[6] + l * 2048};
          pg8::gemm_phase<pg8::EpiMerge, pg8::StaticOrder, true, true>(lds, g, S, E, tl); }
        } else if (sub == 6) {
        { PHASE_ARGS(); TID_NOW(tl); const bfu* WL = (const bfu*)(ws + WS_W) + (size_t)l * WL_ELEMS; const bfu* mb = (const bfu*)(ws + WS_ZLX);
          pg8::Gemm g{mb, mb, mb, mb, WL + WO_O, WL + WO_O, WL + WO_O, WL + WO_O, 1024}; pg8::StaticOrder S; S.init(MTOK, 1024, G, bx, 1);
          pg8::EpiRes E{ap->out, ap->out, (bfu*)(ws + WS_XB), (float*)(ws + WS_RSQ) + (size_t)((3 * l + 2) & 1) * 16 * MTOK, 1.0f};
          pg8::gemm_phase<pg8::EpiRes, pg8::StaticOrder, true, true>(lds, g, S, E, tl); }
        } else if (sub == 7) {
        { PHASE_ARGS(); TID_NOW(tl); const bfu* WL = (const bfu*)(ws + WS_W) + (size_t)l * WL_ELEMS; const bfu* xb = (const bfu*)(ws + WS_XB);
          pg8::Gemm g{xb, xb, xb, xb, WL + WO_UP2, WL + WO_UP2, WL + WO_UP2, WL + WO_UP2, 1024}; pg8::StaticOrder S; S.init(MTOK, 5632, G, bx, 1);
          pg8::EpiUp E{(bfu*)(ws + WS_ACT), (const float*)(ws + WS_RSQ) + (size_t)((3 * l + 2) & 1) * 16 * MTOK};
          pg8::gemm_phase<pg8::EpiUp, pg8::StaticOrder, true, true>(lds, g, S, E, tl); }
        } else {
        { PHASE_ARGS(); TID_NOW(tl); const bfu* WL = (const bfu*)(ws + WS_W) + (size_t)l * WL_ELEMS; const bfu* act = (const bfu*)(ws + WS_ACT);
          const bool more = (l + 1 < NLAYER);
          pg8::Gemm g{act, act, act, act, WL + WO_DN2, WL + WO_DN2, WL + WO_DN2, WL + WO_DN2, 2816}; pg8::StaticOrder S; S.init(MTOK, 1024, G, bx, 1);
          pg8::EpiRes E{ap->out, ap->out, more ? (bfu*)(ws + WS_XB) : nullptr, more ? (float*)(ws + WS_RSQ) + (size_t)((3 * l + 3) & 1) * 16 * MTOK : nullptr, 0.5f};
          pg8::gemm_phase<pg8::EpiRes, pg8::StaticOrder, true, true>(lds, g, S, E, tl); }
        }
        if (ph + 1 < 9 * NLAYER) GRID_SYNC();
    }
}

extern "C" void kernel_launch(void* const* d_in, const int* in_sizes, int n_in, void* d_out, int out_size, void* d_ws, size_t ws_size, hipStream_t stream) {
    static int grid = 0;
    if (grid == 0) {
        if (n_in != 23 || out_size != MTOK * DM || ws_size < WS_END) { fprintf(stderr, "kernel_launch: unexpected problem (n_in %d out %d ws %zu)\n", n_in, out_size, ws_size); grid = -1; return; }
        int dev = 0, cus = 0, per_cu = 0;
        if (hipGetDevice(&dev) != hipSuccess || hipDeviceGetAttribute(&cus, hipDeviceAttributeMultiprocessorCount, dev) != hipSuccess) { grid = -1; return; }
        if (hipFuncSetAttribute((const void*)fwd_megakernel, hipFuncAttributeMaxDynamicSharedMemorySize, LDS_BYTES) != hipSuccess) { fprintf(stderr, "kernel_launch: hipFuncSetAttribute failed\n"); grid = -1; return; }
        if (hipOccupancyMaxActiveBlocksPerMultiprocessor(&per_cu, (const void*)fwd_megakernel, 512, LDS_BYTES) != hipSuccess || per_cu < 1) { fprintf(stderr, "kernel_launch: occupancy query gave %d\n", per_cu); per_cu = 1; }
        (void)hipGetLastError();
        grid = cus * per_cu;
    }
    if (grid < 0) return;
    if (hipMemsetAsync((char*)d_ws + WS_BAR, 0, BAR_BYTES, stream) != hipSuccess) { fprintf(stderr, "kernel_launch: memset of the barrier words failed\n"); return; }
    Args a{};
    for (int i = 0; i < 23; ++i) a.in[i] = (const float*)d_in[i];
    a.out = (float*)d_out; a.ws = (unsigned char*)d_ws;
    void* args[] = {&a};
    hipError_t e = hipLaunchCooperativeKernel((const void*)fwd_megakernel, dim3(grid), dim3(512), args, LDS_BYTES, stream);
    if (e != hipSuccess) fprintf(stderr, "kernel_launch: cooperative launch failed: %s (grid %d)\n", hipGetErrorString(e), grid);
}
```

```cpp
#include <hip/hip_runtime.h>
#include <hip/hip_cooperative_groups.h>
#include <cstdio>
#include <cstdint>
namespace cg = cooperative_groups;
namespace pg8 {
#define PG8_LAS __attribute__((address_space(3)))
typedef unsigned short bf16_t;
typedef short bf16x8 __attribute__((ext_vector_type(8)));
typedef float f32x4 __attribute__((ext_vector_type(4)));
typedef unsigned u32x4 __attribute__((ext_vector_type(4)));
constexpr int BM = 256, BK = 64, HALF = 128, HTB = HALF * BK * 2  , STAGE_BYTES = 8 * HTB, NXCD = 8, WGM = 8;

__host__ __device__ __forceinline__ int lds_byte(int r, int c) { const int st = (r >> 4) * 2 + (c >> 5), rr = r & 15, cc = c & 31, ob = rr * 64 + cc * 2; return st * 1024 + (ob ^ (((ob >> 9) & 1) << 5)); }
__host__ __device__ __forceinline__ void stage_rc(int b, int& R, int& C) { const int st = b / 1024, sb = b % 1024, swz = sb ^ (((sb >> 9) & 1) << 5); R = (st >> 1) * 16 + swz / 64; C = (st & 1) * 32 + (swz % 64) / 2; }
__host__ __device__ __forceinline__ int perm32(int rho) { const int n = rho >> 4, i = rho & 15; return 8 * (i >> 2) + 4 * n + (i & 3); }

struct Unit { int pm, pn, part, pnb; };
struct Gemm { const bf16_t *A0, *A1, *A2, *A3, *B0, *B1, *B2, *B3; int K; };
__device__ __forceinline__ const char* selA(const Gemm& g, int p) { return (const char*)(p == 0 ? g.A0 : p == 1 ? g.A1 : p == 2 ? g.A2 : g.A3); }
__device__ __forceinline__ const char* selB(const Gemm& g, int p) { return (const char*)(p == 0 ? g.B0 : p == 1 ? g.B1 : p == 2 ? g.B2 : g.B3); }

struct StaticOrder {
    int nM, nN, nwg, G, c, np, gp;
    __host__ __device__ void init(int M, int N, int G_, int c_, int np_, int gp_ = 0) { nM = M / BM; nN = N / BM; nwg = nM * nN; G = G_; c = c_; np = np_; gp = gp_; }
    __host__ __device__ bool next(int i, Unit& u) const {
        const int it = i / np; u.part = i - it * np;
        const long L = (long)it * G + c; if (L >= nwg) return false;
        int wgid = (int)L; { const int q = nwg / NXCD, r = nwg % NXCD, xcd = wgid % NXCD, off = wgid / NXCD; wgid = (xcd < r ? xcd * (q + 1) : r * (q + 1) + (xcd - r) * q) + off; }
        const int nig = WGM * nN, gid = wgid / nig, fm = gid * WGM, gsz = (nM - fm) < WGM ? (nM - fm) : WGM;
        u.pm = fm + ((wgid % nig) % gsz); u.pn = (wgid % nig) / gsz; u.pnb = (gp && u.part >= 2) ? 2 * u.pn + (u.part - 2) : u.pn; return true;
    }
    __device__ __forceinline__ void a_ready(const Unit&) const {}
    __device__ __forceinline__ void done(const Unit&) const {}
};

typedef float f32x2 __attribute__((ext_vector_type(2))); typedef __bf16 bf16x2v __attribute__((ext_vector_type(2)));
__device__ __forceinline__ unsigned cvt_pk_bf16(float lo, float hi) { const f32x2 v = {lo, hi}; const bf16x2v b = __builtin_convertvector(v, bf16x2v); return __builtin_bit_cast(unsigned, b); }
__device__ __forceinline__ f32x2 gelu_pk(f32x2 v) {
    const f32x2 av = __builtin_elementwise_abs(v), d = av * 0.2316418882f + 1.0f;
    f32x2 t; t.x = __builtin_amdgcn_rcpf(d.x); t.y = __builtin_amdgcn_rcpf(d.y);
    f32x2 q = t * 0.5307027145f + (-0.7265760135f); q = q * t + 0.7107068705f; q = q * t + (-0.142248368f); q = q * t + 0.127414796f; q = q * t;
    const f32x2 s = (v * v) * (-0.72134752044f);
    f32x2 e; e.x = __builtin_amdgcn_exp2f(s.x); e.y = __builtin_amdgcn_exp2f(s.y);
    const f32x2 m = v * (q * e), r = v - m;
    f32x2 o; o.x = v.x < 0.f ? m.x : r.x; o.y = v.y < 0.f ? m.y : r.y; return o;
}
constexpr float kLog2e = 1.4426950408889634f;
__device__ __forceinline__ float sigm(float x) { return __builtin_amdgcn_rcpf(1.0f + __builtin_amdgcn_exp2f(-kLog2e * x)); }
__device__ __forceinline__ float gelu_tanh(float x) { const float u = x * (1.0f + 0.044715f * x * x); return x * sigm(1.5957691216057308f * u); }
__device__ __forceinline__ void st8(bf16_t* p, const f32x4 a, const f32x4 b) { u32x4 w; w.x = cvt_pk_bf16(a[0], a[1]); w.y = cvt_pk_bf16(a[2], a[3]); w.z = cvt_pk_bf16(b[0], b[1]); w.w = cvt_pk_bf16(b[2], b[3]); *(u32x4*)p = w; }
__device__ __forceinline__ u32x4 ldg16_l2(const void* p) { const unsigned long long lo = __hip_atomic_load((const unsigned long long*)p, __ATOMIC_RELAXED, __HIP_MEMORY_SCOPE_AGENT), hi = __hip_atomic_load((const unsigned long long*)p + 1, __ATOMIC_RELAXED, __HIP_MEMORY_SCOPE_AGENT);
    u32x4 w; w.x = (unsigned)lo; w.y = (unsigned)(lo >> 32); w.z = (unsigned)hi; w.w = (unsigned)(hi >> 32); return w; }
__device__ __forceinline__ void unpk8(const u32x4 w, f32x4& a, f32x4& b) {
    a[0] = __uint_as_float(w.x << 16); a[1] = __uint_as_float(w.x & 0xffff0000u); a[2] = __uint_as_float(w.y << 16); a[3] = __uint_as_float(w.y & 0xffff0000u);
    b[0] = __uint_as_float(w.z << 16); b[1] = __uint_as_float(w.z & 0xffff0000u); b[2] = __uint_as_float(w.w << 16); b[3] = __uint_as_float(w.w & 0xffff0000u); }
__device__ __forceinline__ void ld8(const bf16_t* p, f32x4& a, f32x4& b) { const u32x4 w = *(const u32x4*)p;
    a[0] = __uint_as_float(w.x << 16); a[1] = __uint_as_float(w.x & 0xffff0000u); a[2] = __uint_as_float(w.y << 16); a[3] = __uint_as_float(w.y & 0xffff0000u);
    b[0] = __uint_as_float(w.z << 16); b[1] = __uint_as_float(w.z & 0xffff0000u); b[2] = __uint_as_float(w.w << 16); b[3] = __uint_as_float(w.w & 0xffff0000u); }
constexpr int RSQ_ROWS = 32768;
struct Rs8 { float v[2][4]; };
__device__ __forceinline__ Rs8 load_rstd8(const float* rowsq, int pm, int wr, int fr, int fq) { Rs8 r; f32x4 t[2][4];
    _Pragma("unroll") for (int ai = 0; ai < 2; ++ai) _Pragma("unroll") for (int m = 0; m < 4; ++m) t[ai][m] = *(const f32x4*)(rowsq + (size_t)(pm * BM + ai * HALF + wr * 64 + m * 16 + fr) * 16 + 4 * fq);
    const int ln = fq * 16 + fr;
    _Pragma("unroll") for (int ai = 0; ai < 2; ++ai) _Pragma("unroll") for (int m = 0; m < 4; ++m) { float s = (t[ai][m][0] + t[ai][m][1]) + (t[ai][m][2] + t[ai][m][3]);
        s += __builtin_bit_cast(float, __builtin_amdgcn_ds_bpermute((ln ^ 16) << 2, __builtin_bit_cast(int, s))); s += __builtin_bit_cast(float, __builtin_amdgcn_ds_bpermute((ln ^ 32) << 2, __builtin_bit_cast(int, s)));
        r.v[ai][m] = __builtin_amdgcn_rsqf(s * (1.0f / 1024.0f) + 1e-6f); }
    return r; }
__device__ __forceinline__ Rs8 load_rstd8_direct(const float* rstd, int pm, int wr, int fr) { Rs8 r;
    _Pragma("unroll") for (int ai = 0; ai < 2; ++ai) _Pragma("unroll") for (int m = 0; m < 4; ++m) r.v[ai][m] = rstd[pm * BM + ai * HALF + wr * 64 + m * 16 + fr];
    return r; }
__device__ __forceinline__ float bperm(int srclane, float v) { return __builtin_bit_cast(float, __builtin_amdgcn_ds_bpermute(srclane << 2, __builtin_bit_cast(int, v))); }
#define EPI_ROWS(...) _Pragma("unroll") for (int ai = 0; ai < 2; ++ai) _Pragma("unroll") for (int m = 0; m < 4; ++m) { const int row = u.pm * BM + ai * HALF + wr * 64 + m * 16 + fr; __VA_ARGS__ }

struct EpiUp {
    static constexpr bool PERM = true, AFTER_DRAIN = false;
    bf16_t* O; const float* rowsq;
    __device__ __forceinline__ void operator()(const f32x4 (&acc)[2][2][4][2], const Unit& u, int wr, int wc, int fr_in, int fq_in) const {
        int fr = fr_in, fq = fq_in; asm volatile("" : "+v"(fr), "+v"(fq));
        const int col = u.pn * 128 + wc * 32 + 8 * fq; const Rs8 R = load_rstd8(rowsq, u.pm, wr, fr, fq);
        EPI_ROWS(
            const float rs = R.v[ai][m];
            f32x4 o[2];
            _Pragma("unroll") for (int n = 0; n < 2; ++n) { const f32x4 g = acc[ai][0][m][n] * rs, up = acc[ai][1][m][n] * rs;
                _Pragma("unroll") for (int j = 0; j < 4; ++j) o[n][j] = g[j] * sigm(g[j]) * up[j]; }
            st8(O + (size_t)row * 2816 + col, o[0], o[1]);
        )
    }
};
typedef _Float16 h16x2 __attribute__((ext_vector_type(2)));
__device__ __forceinline__ unsigned cvt_pk_f16(float lo, float hi) { const f32x2 v = {lo, hi}; const h16x2 h = __builtin_convertvector(v, h16x2); return __builtin_bit_cast(unsigned, h); }
__device__ __forceinline__ void unpk8h(const u32x4 w, f32x4& a, f32x4& b) { const unsigned x0 = w[0], x1 = w[1], x2 = w[2], x3 = w[3];
    const f32x2 p0 = __builtin_convertvector(__builtin_bit_cast(h16x2, x0), f32x2), p1 = __builtin_convertvector(__builtin_bit_cast(h16x2, x1), f32x2),
    p2 = __builtin_convertvector(__builtin_bit_cast(h16x2, x2), f32x2), p3 = __builtin_convertvector(__builtin_bit_cast(h16x2, x3), f32x2); a = (f32x4){p0[0], p0[1], p1[0], p1[1]}; b = (f32x4){p2[0], p2[1], p3[0], p3[1]}; }
struct EpiRes {
    static constexpr bool PERM = true, AFTER_DRAIN = false;
    const float* base; const bf16_t* hbase; float* out; bf16_t* hout; bf16_t* xb; float* rsq_next; float scale;
    __device__ __forceinline__ void operator()(const f32x4 (&acc)[2][2][4][2], const Unit& u, int wr, int wc, int fr_in, int fq_in) const {
        int fr = fr_in, fq = fq_in; asm volatile("" : "+v"(fr), "+v"(fq));
        const int col = u.pn * BM + wc * 32 + 8 * fq;
#pragma unroll
        for (int ai = 0; ai < 2; ++ai) { f32x4 bs[4][2][2];
            if (base) {
#pragma unroll
                for (int m = 0; m < 4; ++m)
#pragma unroll
                    for (int bj = 0; bj < 2; ++bj) { const size_t off = (size_t)(u.pm * BM + ai * HALF + wr * 64 + m * 16 + fr) * 1024 + col + bj * HALF; bs[m][bj][0] = *(const f32x4*)(base + off); bs[m][bj][1] = *(const f32x4*)(base + off + 4); }
            } else { u32x4 bw[4][2];
#pragma unroll
                for (int m = 0; m < 4; ++m)
#pragma unroll
                    for (int bj = 0; bj < 2; ++bj) bw[m][bj] = *(const u32x4*)(hbase + (size_t)(u.pm * BM + ai * HALF + wr * 64 + m * 16 + fr) * 1024 + col + bj * HALF);
#pragma unroll
                for (int m = 0; m < 4; ++m)
#pragma unroll
                    for (int bj = 0; bj < 2; ++bj) unpk8h(bw[m][bj], bs[m][bj][0], bs[m][bj][1]); }
#pragma unroll
            for (int m = 0; m < 4; ++m) { const int row = u.pm * BM + ai * HALF + wr * 64 + m * 16 + fr; float ss = 0.f;
#pragma unroll
                for (int bj = 0; bj < 2; ++bj) { const size_t off = (size_t)row * 1024 + col + bj * HALF;
                    const f32x4 o0 = bs[m][bj][0] + acc[ai][bj][m][0] * scale, o1 = bs[m][bj][1] + acc[ai][bj][m][1] * scale;
                    if (out) { *(f32x4*)(out + off) = o0; *(f32x4*)(out + off + 4) = o1; }
                    ss += (o0[0] * o0[0] + o0[1] * o0[1]) + (o0[2] * o0[2] + o0[3] * o0[3]) + (o1[0] * o1[0] + o1[1] * o1[1]) + (o1[2] * o1[2] + o1[3] * o1[3]);
                    if (hout) { u32x4 w; w.x = cvt_pk_f16(o0[0], o0[1]); w.y = cvt_pk_f16(o0[2], o0[3]); w.z = cvt_pk_f16(o1[0], o1[1]); w.w = cvt_pk_f16(o1[2], o1[3]); *(u32x4*)(hout + off) = w; }
                    if (xb) st8(xb + off, o0, o1); }
                if (rsq_next) { const int ln = fq * 16 + fr; ss += bperm(ln ^ 16, ss); ss += bperm(ln ^ 32, ss); if (fq == 0) rsq_next[(size_t)row * 16 + u.pn * 4 + wc] = ss; } }
            asm volatile("" ::: "memory"); }
    }
};
struct EpiZ {
    static constexpr bool PERM = true, AFTER_DRAIN = false;
    bf16_t *ZLX, *G, *Q, *Kb, *V; float* logf; const float* rowsq; const float *gq, *gk, *bforget; float c2; float* rstd2;
    __device__ __forceinline__ void operator()(const f32x4 (&acc)[2][2][4][2], const Unit& u, int wr, int wc, int fr_in, int fq_in) const {
        int fr = fr_in, fq = fq_in; asm volatile("" : "+v"(fr), "+v"(fq));
        const int t = u.pn >> 2, pnl = u.pn & 3; const Rs8 R = load_rstd8(rowsq, u.pm, wr, fr, fq);
        if (t == 0 || t == 4) { bf16_t* O = t == 0 ? ZLX : V; const int col = pnl * BM + wc * 32 + 8 * fq;
            EPI_ROWS( const float rs = R.v[ai][m];
                _Pragma("unroll") for (int bj = 0; bj < 2; ++bj) st8(O + (size_t)row * 1024 + col + bj * HALF, acc[ai][bj][m][0] * rs, acc[ai][bj][m][1] * rs); )
        } else if (t == 1) { const int col = pnl * BM + wc * 32 + 8 * fq;
            EPI_ROWS( const float rs = R.v[ai][m];
                _Pragma("unroll") for (int bj = 0; bj < 2; ++bj) { f32x4 o[2];
                    _Pragma("unroll") for (int n = 0; n < 2; ++n) _Pragma("unroll") for (int j = 0; j < 4; ++j) o[n][j] = gelu_tanh(acc[ai][bj][m][n][j] * rs);
                    st8(G + (size_t)row * 1024 + col + bj * HALF, o[0], o[1]); } )
        } else if (t == 2 || t == 3) {
            bf16_t* O = t == 2 ? Q : Kb; const float* gn = t == 2 ? gq : gk; const float sc = t == 2 ? c2 : 1.0f;
            const int col = (pnl * 4 + wc) * 64 + 8 * fq;
            f32x4 gv[2][2];
            _Pragma("unroll") for (int bj = 0; bj < 2; ++bj) _Pragma("unroll") for (int n = 0; n < 2; ++n) gv[bj][n] = *(const f32x4*)(gn + 32 * bj + 8 * fq + 4 * n) * sc;
            EPI_ROWS( const float rs = R.v[ai][m];
                f32x4 v[2][2]; float ss = 0.f;
                _Pragma("unroll") for (int bj = 0; bj < 2; ++bj) _Pragma("unroll") for (int n = 0; n < 2; ++n) { v[bj][n] = acc[ai][bj][m][n] * rs; const f32x4 q = v[bj][n] * v[bj][n]; ss += (q[0] + q[1]) + (q[2] + q[3]); }
                { const int ln = fq * 16 + fr; ss += bperm(ln ^ 16, ss); ss += bperm(ln ^ 32, ss); }
                const float rn = __builtin_amdgcn_rsqf(ss * (1.0f / 64.0f) + 1e-6f);
                _Pragma("unroll") for (int bj = 0; bj < 2; ++bj) st8(O + (size_t)row * 1024 + col + 32 * bj, v[bj][0] * rn * gv[bj][0], v[bj][1] * rn * gv[bj][1]); )
        } else {
            if (wc == 0 && fq < 2) {
                f32x4 bf0 = *(const f32x4*)(bforget + 8 * fq), bf1 = *(const f32x4*)(bforget + 8 * fq + 4);
                EPI_ROWS( const float rs = R.v[ai][m]; f32x4 o[2];
                    _Pragma("unroll") for (int n = 0; n < 2; ++n) _Pragma("unroll") for (int j = 0; j < 4; ++j) { const float x = acc[ai][0][m][n][j] * rs + (n == 0 ? bf0[j] : bf1[j]);
                        o[n][j] = fminf(x, 0.f) - log1pf(__expf(-fabsf(x))); }
                    *(f32x4*)(logf + (size_t)row * 16 + 8 * fq) = o[0]; *(f32x4*)(logf + (size_t)row * 16 + 8 * fq + 4) = o[1]; if (fq == 0) rstd2[row] = rs; )
            }
        }
    }
};
struct EpiMerge {
    static constexpr bool PERM = true, AFTER_DRAIN = false;
    bf16_t *Y1, *Y2, *MB; const float* rstd2; const float* bgate;
    __device__ __forceinline__ void operator()(const f32x4 (&acc)[2][2][4][2], const Unit& u, int wr, int wc, int fr_in, int fq_in) const {
        int fr = fr_in, fq = fq_in; asm volatile("" : "+v"(fr), "+v"(fq));
        if (u.part < 2) { bf16_t* O = u.part == 0 ? Y1 : Y2; const int col = u.pn * BM + wc * 32 + 8 * fq;
            EPI_ROWS( _Pragma("unroll") for (int bj = 0; bj < 2; ++bj) st8(O + (size_t)row * 1024 + col + bj * HALF, acc[ai][bj][m][0], acc[ai][bj][m][1]); )
        } else {
            const int col = u.pn * BM + (u.part - 2) * HALF + wc * 32 + 8 * fq;
            const Rs8 R = load_rstd8_direct(rstd2, u.pm, wr, fr);
            f32x4 ba[2], bb[2];
#pragma unroll
            for (int n = 0; n < 2; ++n) { ba[n] = *(const f32x4*)(bgate + col + 4 * n); bb[n] = *(const f32x4*)(bgate + 1024 + col + 4 * n); }
#pragma unroll
            for (int ai = 0; ai < 2; ++ai) { u32x4 y1w[4], y2w[4];
#pragma unroll
                for (int m = 0; m < 4; ++m) { const size_t off = (size_t)(u.pm * BM + ai * HALF + wr * 64 + m * 16 + fr) * 1024 + col; y1w[m] = *(const u32x4*)(Y1 + off); y2w[m] = *(const u32x4*)(Y2 + off); }
#pragma unroll
                for (int m = 0; m < 4; ++m) { const int row = u.pm * BM + ai * HALF + wr * 64 + m * 16 + fr; const float rs = R.v[ai][m];
                    f32x4 a0, a1, b0, b1; unpk8(y1w[m], a0, a1); unpk8(y2w[m], b0, b1); f32x4 o[2];
#pragma unroll
                    for (int j = 0; j < 4; ++j) {
                        o[0][j] = sigm(acc[ai][0][m][0][j] * rs + ba[0][j]) * a0[j] + sigm(acc[ai][1][m][0][j] * rs + bb[0][j]) * b0[j];
                        o[1][j] = sigm(acc[ai][0][m][1][j] * rs + ba[1][j]) * a1[j] + sigm(acc[ai][1][m][1][j] * rs + bb[1][j]) * b1[j]; }
                    st8(MB + (size_t)row * 1024 + col, o[0], o[1]); }
                asm volatile("" ::: "memory"); }
        }
    }
};
template <class Epi, class Sched, bool ALIGN_EPI = false, bool SP2 = false>
__device__ __forceinline__ void gemm_phase(PG8_LAS unsigned char* lds, const Gemm g, const Sched& S, const Epi& E, const int tid) {
    const int wid = __builtin_amdgcn_readfirstlane(tid >> 6), lane = tid & 63, wr = wid >> 2, wc = wid & 3, fr = lane & 15, fq = lane >> 4;
    const int K = g.K, nt = K / BK;
    unsigned voffA[2], voffB[2];
#pragma unroll
    for (int i = 0; i < 2; ++i) { int R, C; stage_rc(tid * 16 + i * 8192, R, C); const int Rb = Epi::PERM ? ((R & ~31) + perm32(R & 31)) : R;
        voffA[i] = (unsigned)(R * K + C) * 2u; voffB[i] = (unsigned)(Rb * K + C) * 2u; }
    const size_t kstep = (size_t)(BK * 2);
    const size_t hstep = (size_t)HALF * K * 2;
    const size_t tstep = 2 * hstep;
    const unsigned ldsw = (unsigned)wid * 1024u;
    const int aoff = lds_byte(wr * 64 + fr, fq * 8), boff = lds_byte(wc * 32 + fr, fq * 8);
#define PG8_SA(b, h) (((b) * 2 + (h)) * HTB)
#define PG8_SB(b, h) ((4 + (b) * 2 + (h)) * HTB)
#define PG8_STAGE(bufoff, gbase, voff) do { _Pragma("unroll") for (int _i = 0; _i < 2; ++_i) \
        __builtin_amdgcn_global_load_lds((const unsigned*)((const char*)(gbase) + (voff)[_i]), (PG8_LAS unsigned*)(lds + (bufoff) + ldsw + _i * 8192), 16, 0, 0); } while (0)
#define PG8_LDA(dst, b, h) do { _Pragma("unroll") for (int m = 0; m < 4; ++m) _Pragma("unroll") for (int k = 0; k < 2; ++k) dst[m][k] = *(const PG8_LAS bf16x8*)(lds + PG8_SA(b, h) + aoff + m * 2048 + k * 1024); } while (0)
#define PG8_LDB(dst, b, h) do { _Pragma("unroll") for (int n = 0; n < 2; ++n) _Pragma("unroll") for (int k = 0; k < 2; ++k) dst[n][k] = *(const PG8_LAS bf16x8*)(lds + PG8_SB(b, h) + boff + n * 2048 + k * 1024); } while (0)
#define PG8_MMA(ai, bj, At, Bt) do { __builtin_amdgcn_s_setprio(1); _Pragma("unroll") for (int m = 0; m < 4; ++m) _Pragma("unroll") for (int n = 0; n < 2; ++n) _Pragma("unroll") for (int k = 0; k < 2; ++k) \
        acc[ai][bj][m][n] = __builtin_amdgcn_mfma_f32_16x16x32_bf16(Bt[n][k], At[m][k], acc[ai][bj][m][n], 0, 0, 0); __builtin_amdgcn_s_setprio(0); } while (0)
#define PG8_WAIT_V(n) asm volatile("s_waitcnt vmcnt(" #n ")" ::: "memory")
#define PG8_WAIT_L(n) asm volatile("s_waitcnt lgkmcnt(" #n ")" ::: "memory")
#define PG8_BAR __builtin_amdgcn_s_barrier()
#define PG8_SCHED __builtin_amdgcn_sched_barrier(0)
    Unit cur, nxt; int ui = 0;
    if (!S.next(0, cur)) return;
    f32x4 acc[2][2][4][2];
#pragma unroll
    for (int a = 0; a < 2; ++a)
#pragma unroll
        for (int b = 0; b < 2; ++b)
#pragma unroll
            for (int m = 0; m < 4; ++m)
#pragma unroll
                for (int n = 0; n < 2; ++n) acc[a][b][m][n] = (f32x4){0.f, 0.f, 0.f, 0.f};
    bf16x8 At[4][2], B0[2][2], B1[2][2];
    const char* cA = selA(g, cur.part) + (size_t)cur.pm * tstep; const char* cB = selB(g, cur.part) + (size_t)cur.pnb * tstep;
    S.a_ready(cur);
    if constexpr (SP2) {
        PG8_STAGE(PG8_SB(0, 0), cB, voffB); PG8_STAGE(PG8_SB(0, 1), cB + hstep, voffB); PG8_STAGE(PG8_SA(0, 0), cA, voffA); PG8_STAGE(PG8_SA(0, 1), cA + hstep, voffA);
        if (wr == 1) PG8_BAR;
        PG8_WAIT_V(2); PG8_BAR;
        PG8_STAGE(PG8_SB(1, 0), cB + kstep, voffB); PG8_STAGE(PG8_SA(1, 0), cA + kstep, voffA); PG8_STAGE(PG8_SB(1, 1), cB + hstep + kstep, voffB);
        PG8_WAIT_V(6); PG8_BAR;
    } else {
        PG8_STAGE(PG8_SB(0, 0), cB, voffB); PG8_STAGE(PG8_SA(0, 0), cA, voffA); PG8_STAGE(PG8_SB(0, 1), cB + hstep, voffB); PG8_STAGE(PG8_SA(0, 1), cA + hstep, voffA);
        if (wr == 1) PG8_BAR;
        PG8_WAIT_V(4); PG8_BAR;
        PG8_STAGE(PG8_SB(1, 0), cB + kstep, voffB); PG8_STAGE(PG8_SA(1, 0), cA + kstep, voffA); PG8_STAGE(PG8_SB(1, 1), cB + hstep + kstep, voffB);
        PG8_WAIT_V(6); PG8_BAR;
    }
    for (;;) {
        const bool has_next = S.next(ui + 1, nxt);
        const char* nA = has_next ? selA(g, nxt.part) + (size_t)nxt.pm * tstep : cA; const char* nB = has_next ? selB(g, nxt.part) + (size_t)nxt.pnb * tstep : cB;
        for (int t = 0; t < nt; t += 2) {
            const bool last = (t == nt - 2);
            const char* a1 = cA + (size_t)(t + 1) * kstep;
            const char* a2 = last ? nA : cA + (size_t)(t + 2) * kstep; const char* b2 = last ? nB : cB + (size_t)(t + 2) * kstep;
            const char* a3 = a2 + kstep; const char* b3 = b2 + kstep;
            if (last && has_next) S.a_ready(nxt);
            if constexpr (SP2) {
            PG8_LDB(B0, 0, 0); PG8_LDB(B1, 0, 1); PG8_SCHED; PG8_LDA(At, 0, 0); PG8_STAGE(PG8_SA(1, 1), a1 + hstep, voffA);
            PG8_WAIT_V(8); PG8_WAIT_L(0); PG8_BAR; PG8_MMA(0, 0, At, B0); PG8_MMA(0, 1, At, B1); PG8_BAR; PG8_SCHED;
            PG8_LDA(At, 0, 1); PG8_STAGE(PG8_SB(0, 0), b2, voffB); PG8_STAGE(PG8_SB(0, 1), b2 + hstep, voffB); PG8_STAGE(PG8_SA(0, 0), a2, voffA);
            PG8_WAIT_V(8); PG8_WAIT_L(0); PG8_BAR; PG8_MMA(1, 0, At, B0); PG8_MMA(1, 1, At, B1); PG8_BAR; PG8_SCHED;
            PG8_LDB(B0, 1, 0); PG8_LDB(B1, 1, 1); PG8_SCHED; PG8_LDA(At, 1, 0); PG8_STAGE(PG8_SA(0, 1), a2 + hstep, voffA);
            PG8_WAIT_V(8); PG8_WAIT_L(0); PG8_BAR; PG8_MMA(0, 0, At, B0); PG8_MMA(0, 1, At, B1); PG8_BAR; PG8_SCHED;
            PG8_LDA(At, 1, 1); PG8_STAGE(PG8_SB(1, 0), b3, voffB); PG8_STAGE(PG8_SB(1, 1), b3 + hstep, voffB); PG8_STAGE(PG8_SA(1, 0), a3, voffA);
            PG8_WAIT_V(8); PG8_WAIT_L(0); PG8_BAR; PG8_MMA(1, 0, At, B0); PG8_MMA(1, 1, At, B1); PG8_BAR; PG8_SCHED;
            } else {
            PG8_LDB(B0, 0, 0); PG8_SCHED; PG8_LDA(At, 0, 0); PG8_STAGE(PG8_SA(1, 1), a1 + hstep, voffA);
            PG8_WAIT_L(8); PG8_BAR; PG8_WAIT_L(0); PG8_MMA(0, 0, At, B0); PG8_BAR; PG8_SCHED;
            PG8_LDB(B1, 0, 1); PG8_STAGE(PG8_SB(0, 0), b2, voffB);
            PG8_BAR; PG8_WAIT_L(0); PG8_MMA(0, 1, At, B1); PG8_BAR;
            PG8_LDA(At, 0, 1); PG8_STAGE(PG8_SA(0, 0), a2, voffA);
            PG8_BAR; PG8_WAIT_L(0); PG8_MMA(1, 0, At, B0); PG8_BAR; PG8_SCHED;
            PG8_STAGE(PG8_SB(0, 1), b2 + hstep, voffB);
            PG8_WAIT_V(6); PG8_BAR; PG8_MMA(1, 1, At, B1); PG8_BAR;
            PG8_LDB(B0, 1, 0); PG8_SCHED; PG8_LDA(At, 1, 0); PG8_STAGE(PG8_SA(0, 1), a2 + hstep, voffA);
            PG8_WAIT_L(8); PG8_BAR; PG8_WAIT_L(0); PG8_MMA(0, 0, At, B0); PG8_BAR; PG8_SCHED;
            PG8_LDB(B1, 1, 1); PG8_STAGE(PG8_SB(1, 0), b3, voffB);
            PG8_BAR; PG8_WAIT_L(0); PG8_MMA(0, 1, At, B1); PG8_BAR;
            PG8_LDA(At, 1, 1); PG8_STAGE(PG8_SA(1, 0), a3, voffA);
            PG8_BAR; PG8_WAIT_L(0); PG8_MMA(1, 0, At, B0); PG8_BAR; PG8_SCHED;
            PG8_STAGE(PG8_SB(1, 1), b3 + hstep, voffB);
            PG8_WAIT_V(6); PG8_BAR; PG8_MMA(1, 1, At, B1); PG8_BAR;
            }
        }
        if constexpr (ALIGN_EPI) { if (wr == 0) PG8_BAR; }
        if constexpr (!Epi::AFTER_DRAIN) { E(acc, cur, wr, wc, fr, fq); S.done(cur); }
        if (!has_next) break;
#pragma unroll
        for (int a = 0; a < 2; ++a)
#pragma unroll
            for (int b = 0; b < 2; ++b)
#pragma unroll
                for (int m = 0; m < 4; ++m)
#pragma unroll
                    for (int n = 0; n < 2; ++n) acc[a][b][m][n] = (f32x4){0.f, 0.f, 0.f, 0.f};
        cur = nxt; cA = nA; cB = nB; ++ui;
        if constexpr (ALIGN_EPI) { if (wr == 1) PG8_BAR; }
    }
    PG8_WAIT_V(0);
    if constexpr (!ALIGN_EPI) { if (wr == 0) PG8_BAR; }
    PG8_BAR;
    if constexpr (Epi::AFTER_DRAIN) { E.fused(acc, cur, wr, wc, fr, fq, lds, wid, lane); S.done(cur); }
#undef PG8_SA
#undef PG8_SB
#undef PG8_STAGE
#undef PG8_LDA
#undef PG8_LDB
#undef PG8_MMA
#undef PG8_WAIT_V
#undef PG8_WAIT_L
#undef PG8_BAR
#undef PG8_SCHED
}
}

#include <hip/hip_bf16.h>
#include <cmath>
namespace attn_body {
using bf16=__hip_bfloat16;
using bf16x8=__attribute__((ext_vector_type(8)))short;
using s16x4=__attribute__((ext_vector_type(4)))short;
using f32x16=__attribute__((ext_vector_type(16)))float;
using u32x4=__attribute__((ext_vector_type(4)))unsigned;
using f32x4v=__attribute__((ext_vector_type(4)))float;
constexpr int BATCH=16,NHEAD=16,SEQ=2048,D=64,DM=NHEAD*D;
constexpr int NW=8,QBLK=32,QB=QBLK*NW,KVBLK=64,NQB=SEQ/QB;
constexpr int ATTN_PITCH=DM, ATTN_UNIT_ROWS=QB;
__device__ __forceinline__ int crow(int r,int hi){return (r&3)+8*(r>>2)+4*hi;}
#define SBAR() __builtin_amdgcn_sched_barrier(0)
__device__ __forceinline__ void cmask(f32x16&p0,f32x16&p1,int jb,int qrel,int hi){
  const float NEG=-INFINITY; int kb=64*jb+4*hi;
  #pragma unroll
  for(int r=0;r<16;++r){int kv=kb+(r&3)+8*(r>>2); if(kv>qrel)p0[r]=NEG; if(kv+32>qrel)p1[r]=NEG;}
}

constexpr int NSLOT=3, SLOTB=8192;
constexpr int LDS_K=0, LDS_V=NSLOT*SLOTB, LDS_WS=2*NSLOT*SLOTB, LDS_OST=LDS_WS+NW*64*4, LDS_NB=LDS_OST+NW*4096, LDS_BYTES=LDS_NB+(SEQ+64)*4;
constexpr float C2=0.125f*1.4426950408889634f;
__device__ __forceinline__ void glds16s(const void*sbase,unsigned voff,unsigned lds_dst){unsigned keep;
  asm volatile("s_mov_b32 %0, m0\n\ts_mov_b32 m0, %2\n\ts_nop 0\n\tglobal_load_lds_dwordx4 %1, %3\n\ts_mov_b32 m0, %0":"=&s"(keep):"v"(voff),"s"(lds_dst),"s"(sbase):"memory");}
__device__ __forceinline__ void glds16(const void*gsrc,unsigned lds_dst){unsigned keep;
  asm volatile("s_mov_b32 %0, m0\n\ts_mov_b32 m0, %2\n\ts_nop 0\n\tglobal_load_lds_dwordx4 %1, off\n\ts_mov_b32 m0, %0":"=&s"(keep):"v"(gsrc),"s"(lds_dst):"memory");}
__device__ __forceinline__ float max3f(float a,float b,float c){float r;asm("v_max3_f32 %0, %1, %2, %3":"=v"(r):"v"(a),"v"(b),"v"(c));return r;}
__device__ __forceinline__ float max2f(float a,float b){float r;asm("v_max_f32_e32 %0, %1, %2":"=v"(r):"v"(a),"v"(b));return r;}
__device__ __forceinline__ float fadd_s(float a,float b){float r;asm("v_add_f32_e32 %0, %1, %2":"=v"(r):"v"(a),"v"(b));return r;}
__device__ __forceinline__ float fsub_s(float a,float b){float r;asm("v_sub_f32_e32 %0, %1, %2":"=v"(r):"v"(a),"v"(b));return r;}
typedef float f32x2_t __attribute__((ext_vector_type(2))); typedef __bf16 bf16x2_t __attribute__((ext_vector_type(2)));
__device__ __forceinline__ unsigned cvtpk_s(float lo,float hi){f32x2_t v={lo,hi};bf16x2_t b=__builtin_convertvector(v,bf16x2_t);return __builtin_bit_cast(unsigned,b);}
#define WAIT_BAR(N) asm volatile("s_waitcnt vmcnt(" #N ") lgkmcnt(0)\n\ts_barrier":::"memory")

__device__ __forceinline__ void qkt(f32x16&p0,f32x16&p1,const char*Kslot,const bf16x8*qr,int r32,int hi){
  const char*kb=Kslot+hi*1024+r32*16;
  #pragma unroll
  for(int d0=0;d0<4;++d0){
    const bf16x8 b0=*reinterpret_cast<const bf16x8*>(kb+d0*2048);
    const bf16x8 b1=*reinterpret_cast<const bf16x8*>(kb+d0*2048+512);
    p0=__builtin_amdgcn_mfma_f32_32x32x16_bf16(b0,qr[d0],p0,0,0,0);p1=__builtin_amdgcn_mfma_f32_32x32x16_bf16(b1,qr[d0],p1,0,0,0);}
}
typedef __attribute__((address_space(3))) const char* lds_cptr;
typedef short v4i16_t __attribute__((ext_vector_type(4)));
__device__ __forceinline__ void kload8(bf16x8*kf,lds_cptr kp){
  kf[0]=*(const __attribute__((address_space(3))) bf16x8*)(kp);      kf[1]=*(const __attribute__((address_space(3))) bf16x8*)(kp+512);
  kf[2]=*(const __attribute__((address_space(3))) bf16x8*)(kp+2048); kf[3]=*(const __attribute__((address_space(3))) bf16x8*)(kp+2560);
  kf[4]=*(const __attribute__((address_space(3))) bf16x8*)(kp+4096); kf[5]=*(const __attribute__((address_space(3))) bf16x8*)(kp+4608);
  kf[6]=*(const __attribute__((address_space(3))) bf16x8*)(kp+6144); kf[7]=*(const __attribute__((address_space(3))) bf16x8*)(kp+6656);
}
__device__ __forceinline__ void kload2(bf16x8*kf,lds_cptr kp,int j){ kf[2*j]=*(const __attribute__((address_space(3))) bf16x8*)(kp+j*2048); kf[2*j+1]=*(const __attribute__((address_space(3))) bf16x8*)(kp+j*2048+512); }
__device__ __forceinline__ s16x4 vtr(lds_cptr p){ return __builtin_bit_cast(s16x4,__builtin_amdgcn_ds_read_tr16_b64_v4i16((__attribute__((address_space(3))) v4i16_t*)p)); }
__device__ __forceinline__ float rowmax(const f32x16&p0,const f32x16&p1){
  float a=max3f(p0[0],p0[1],p1[0]),b=max3f(p0[2],p0[3],p1[1]);a=max3f(a,p1[2],p1[3]);
  #pragma unroll
  for(int r=4;r<16;r+=4){a=max3f(a,p0[r],p0[r+1]);b=max3f(b,p0[r+2],p0[r+3]);a=max3f(a,p1[r],p1[r+1]);b=max3f(b,p1[r+2],p1[r+3]);}
  const float m=max2f(a,b);
  auto rr=__builtin_amdgcn_permlane32_swap(__float_as_uint(m),__float_as_uint(m),false,false);
  return max2f(__uint_as_float(rr[0]),__uint_as_float(rr[1]));
}
__device__ __forceinline__ void pv(f32x16*o,int vb,bf16x8 pa0,bf16x8 pa1,bf16x8 pa2,bf16x8 pa3){
  #pragma unroll
  for(int d0=0;d0<2;++d0){s16x4 lo[4],hi[4];
    #pragma unroll
    for(int ks=0;ks<4;++ks){
      asm volatile("ds_read_b64_tr_b16 %0,%1 offset:%c2":"=&v"(lo[ks]):"v"(vb),"i"(d0*4096+ks*1024):"memory");
      asm volatile("ds_read_b64_tr_b16 %0,%1 offset:%c2":"=&v"(hi[ks]):"v"(vb),"i"(d0*4096+ks*1024+512):"memory");}
    asm volatile("s_waitcnt lgkmcnt(0)":::"memory");SBAR();
    #define PK(k) (bf16x8){lo[k][0],lo[k][1],lo[k][2],lo[k][3],hi[k][0],hi[k][1],hi[k][2],hi[k][3]}
    o[d0]=__builtin_amdgcn_mfma_f32_32x32x16_bf16(pa0,PK(0),o[d0],0,0,0);
    o[d0]=__builtin_amdgcn_mfma_f32_32x32x16_bf16(pa1,PK(1),o[d0],0,0,0);
    o[d0]=__builtin_amdgcn_mfma_f32_32x32x16_bf16(pa2,PK(2),o[d0],0,0,0);
    o[d0]=__builtin_amdgcn_mfma_f32_32x32x16_bf16(pa3,PK(3),o[d0],0,0,0);
    #undef PK
  }
}

#ifndef ATTN_STORE16
#define ATTN_STORE16(p,v) (*(u32x4*)(p)=(v))
#endif
template<int THRL> __device__ __forceinline__ void attn_unit(int b,int h,int qb,const bf16*Q,const bf16*__restrict__ K,const bf16*__restrict__ V,bf16*O,char*shm,const int tid,const int tstart,const int tbl_off){
  const int lane=tid&63,r32=lane&31,hi=lane>>5; const int wid=__builtin_amdgcn_readfirstlane(tid>>6);
  const long rowbase=(long)b*SEQ; const int q0=qb*QB;
  const bf16*Qw=Q+(rowbase+q0+wid*QBLK)*DM+h*D;
  const bf16*Kh=K+(rowbase+(long)tstart*KVBLK)*DM+h*D,*Vh=V+(rowbase+(long)tstart*KVBLK)*DM+h*D;
  const unsigned lds0=(unsigned)(uintptr_t)shm;
  float*wsf=(float*)(shm+LDS_WS)+wid*64;
  const unsigned koff=(unsigned)(lane*DM+wid*8)*2u;
  const unsigned voffv=(unsigned)((16*(wid&3)+(lane>>2))*DM+(wid>>2)*32+(lane&3)*8)*2u;
  const unsigned kdst=lds0+LDS_K+wid*1024, vdst=lds0+LDS_V+wid*1024;
  #define DMA_K(t,slot) glds16s(Kh+(long)(t)*KVBLK*DM,koff,(unsigned)__builtin_amdgcn_readfirstlane(kdst+(slot)))
  #define DMA_V(t,slot) glds16s(Vh+(long)(t)*KVBLK*DM,voffv,(unsigned)__builtin_amdgcn_readfirstlane(vdst+(slot)))
  const int vb0=(int)(lds0+LDS_V)+((lane>>4)&1)*32+(lane&3)*8+(4*hi+((lane&15)>>2))*64;
  const char*Kbase=shm+LDS_K; bf16x8 kf[8];
  const lds_cptr shm3=(lds_cptr)shm; const lds_cptr kp0=shm3+LDS_K+hi*1024+r32*16; const lds_cptr vp0=shm3+LDS_V+((lane>>4)&1)*32+(lane&3)*8+(4*hi+((lane&15)>>2))*64;
  const int NT=(q0+QB)/KVBLK-tstart;
  typedef __attribute__((address_space(3))) const f32x4v* nb_cptr;
  const nb_cptr nb0=(nb_cptr)(shm3+LDS_NB+tbl_off)+hi+16*tstart;
  #define BLOAD1(X0,t,H) do{ const nb_cptr p_=nb0+16*(t)+8*(H); \
    _Pragma("unroll") for(int j_=0;j_<4;++j_){ const f32x4v a_=p_[2*j_]; \
      X0[4*j_]=a_[0]-mhat;X0[4*j_+1]=a_[1]-mhat;X0[4*j_+2]=a_[2]-mhat;X0[4*j_+3]=a_[3]-mhat; } asm volatile("":"+v"(X0)); }while(0)
  #define BLOAD(X0,X1,t) do{ BLOAD1(X0,t,0); BLOAD1(X1,t,1); }while(0)
  #define BSUB16(X) do{ _Pragma("unroll") for(int r_=0;r_<16;++r_)X[r_]-=mhat; asm volatile("":"+v"(X)); }while(0)
  DMA_K(0,0);DMA_V(0,0);DMA_K(1,SLOTB);
  bf16x8 qr[4];
  #pragma unroll
  for(int d0=0;d0<4;++d0)qr[d0]=*reinterpret_cast<const bf16x8*>(&Qw[(long)r32*DM+d0*16+hi*8]);
  float mhat=0.f,l_reg=0.f;f32x16 o[2];o[0]=f32x16{};o[1]=f32x16{};
  const int qrel=wid*QBLK+r32;
  #define CMASK(P0,P1,t) do{int jb_=(t)-(NT-4); if(jb_>=0)cmask(P0,P1,jb_,qrel,hi);}while(0)
  bool resc=false;
  #define START(P0,P1) do{ const float rm=rowmax(P0,P1); resc=false; \
    { const float dl=rm; mhat=fadd_s(mhat,dl); \
      _Pragma("unroll") for(int r=0;r<16;++r){P0[r]=fsub_s(P0[r],dl);P1[r]=fsub_s(P1[r],dl);} } \
    _Pragma("unroll") for(int r=0;r<16;++r)P0[r]=__builtin_amdgcn_exp2f(P0[r]); }while(0)
  #define RESC() do{ if(resc){ asm volatile("s_waitcnt lgkmcnt(0)":::"memory"); \
      _Pragma("unroll") for(int d_=0;d_<2;++d_) _Pragma("unroll") for(int r=0;r<16;++r)o[d_][r]*=wsf[crow(r,hi)]; } }while(0)
  f32x16 pA0,pA1,pB0,pB1;
  int sl_prev=0,sl_cur=0,sl_next=SLOTB;
  #define ROT() do{sl_prev=sl_cur;sl_cur=sl_next;sl_next=(sl_next==(NSLOT-1)*SLOTB)?0:sl_next+SLOTB;}while(0)
  DMA_K(2,2*SLOTB);
  WAIT_BAR(3);
  BLOAD(pA0,pA1,0); qkt(pA0,pA1,Kbase,qr,r32,hi);asm volatile("s_nop 15\n\ts_nop 7":"+v"(pA0),"+v"(pA1));CMASK(pA0,pA1,0);
  START(pA0,pA1);
  _Pragma("unroll") for(int r=0;r<16;++r)pA1[r]=__builtin_amdgcn_exp2f(pA1[r]);
  WAIT_BAR(0);
  DMA_K(3,0);DMA_V(1,SLOTB);
  ROT();
  kload8(kf,kp0+sl_cur);
  WAIT_BAR(2);
  s16x4 vlo[8],vhi[8]; u32x4 pw0,pw1,pw2,pw3;
  #define PKW(P,B) cvtpk_s(P[B],P[B+1])
  #define PAF(k) __builtin_bit_cast(bf16x8,pw##k)
  #define VFR(i) (bf16x8){vlo[i][0],vlo[i][1],vlo[i][2],vlo[i][3],vhi[i][0],vhi[i][1],vhi[i][2],vhi[i][3]}
  #define PIN(x) asm volatile("":"+v"(x))
  #define MX3(a,b,c) __builtin_fmaxf(__builtin_fmaxf((a),(b)),(c))
  #define GAPA(MF,A0,A1,A2,A3,W0,W1,PW) do{ MF; sacc+=A0; sacc+=A1; sacc+=A2; sacc+=A3; PIN(sacc); W0; W1; PIN(PW); SBAR(); }while(0)
  #define EX(v) __builtin_amdgcn_exp2f(v)
  #define GAPB(MF,X,B) do{ MF; X[B]=EX(X[B]); X[B+1]=EX(X[B+1]); X[B+2]=EX(X[B+2]); X[B+3]=EX(X[B+3]); PIN(X); SBAR(); }while(0)
  #define VRD(i) do{ vlo[i]=vtr(vp_+(((i)>>2)*4096+((i)&3)*1024)); vhi[i]=vtr(vp_+(((i)>>2)*4096+((i)&3)*1024+512)); }while(0)
  #define KRD(G,j) do{ if(G){ kload2(kf,kp0+sl_next,j); SBAR(); } }while(0)
  #define STEP(C0,C1,P0,P1,t,GK,GV,GL) do{ SBAR(); \
    const lds_cptr vp_=vp0+sl_prev; \
    BLOAD1(C0,t,0); VRD(0); SBAR(); float sacc=(P0[0]+P0[1]); \
    GAPA(C0=__builtin_amdgcn_mfma_f32_32x32x16_bf16(kf[0],qr[0],C0,0,0,0), P0[2],P0[3],P0[4],P0[5],     pw0[0]=PKW(P0,0), pw0[1]=PKW(P0,2), pw0); \
    BLOAD1(C1,t,1); VRD(4); SBAR(); GAPA(C1=__builtin_amdgcn_mfma_f32_32x32x16_bf16(kf[1],qr[0],C1,0,0,0), P0[6],P0[7],P0[8],P0[9],     pw0[2]=PKW(P0,4), pw0[3]=PKW(P0,6), pw0); \
    VRD(1); SBAR(); GAPA(C0=__builtin_amdgcn_mfma_f32_32x32x16_bf16(kf[2],qr[1],C0,0,0,0),   P0[10],P0[11],P0[12],P0[13], pw1[0]=PKW(P0,8), pw1[1]=PKW(P0,10), pw1); \
    VRD(5); SBAR(); GAPA(C1=__builtin_amdgcn_mfma_f32_32x32x16_bf16(kf[3],qr[1],C1,0,0,0),   P0[14],P0[15],P1[0],P1[1],   pw1[2]=PKW(P0,12),pw1[3]=PKW(P0,14), pw1); \
    VRD(2); SBAR(); GAPA(C0=__builtin_amdgcn_mfma_f32_32x32x16_bf16(kf[4],qr[2],C0,0,0,0),   P1[2],P1[3],P1[4],P1[5],     pw2[0]=PKW(P1,0), pw2[1]=PKW(P1,2), pw2); \
    VRD(6); SBAR(); GAPA(C1=__builtin_amdgcn_mfma_f32_32x32x16_bf16(kf[5],qr[2],C1,0,0,0),   P1[6],P1[7],P1[8],P1[9],     pw2[2]=PKW(P1,4), pw2[3]=PKW(P1,6), pw2); \
    VRD(3); SBAR(); GAPA(C0=__builtin_amdgcn_mfma_f32_32x32x16_bf16(kf[6],qr[3],C0,0,0,0),   P1[10],P1[11],P1[12],P1[13], pw3[0]=PKW(P1,8), pw3[1]=PKW(P1,10), pw3); \
    VRD(7); SBAR(); GAPA(C1=__builtin_amdgcn_mfma_f32_32x32x16_bf16(kf[7],qr[3],C1,0,0,0),   P1[14],P1[15],0.f,0.f,       pw3[2]=PKW(P1,12),pw3[3]=PKW(P1,14), pw3); \
    l_reg+=sacc; \
    if(GK){DMA_K((t)+3,sl_cur);} if(GV){DMA_V((t)+1,sl_next);} \
    CMASK(C0,C1,t); \
    { float a=MX3(C0[0],C0[1],C1[0]),b=MX3(C0[2],C0[3],C1[1]); a=MX3(a,C1[2],C1[3]); \
      _Pragma("unroll") for(int r=4;r<16;r+=4){a=MX3(a,C0[r],C0[r+1]);b=MX3(b,C0[r+2],C0[r+3]);a=MX3(a,C1[r],C1[r+1]);b=MX3(b,C1[r+2],C1[r+3]);} \
      float rm=__builtin_fmaxf(a,b); { auto rr=__builtin_amdgcn_permlane32_swap(__float_as_uint(rm),__float_as_uint(rm),false,false); rm=__builtin_fmaxf(__uint_as_float(rr[0]),__uint_as_float(rr[1])); } \
      resc=false; \
      if(__builtin_expect(__any(rm>(float)THRL),0)){ const float dl=__builtin_fmaxf(rm,0.f); mhat+=dl; \
        _Pragma("unroll") for(int r=0;r<16;++r){C0[r]-=dl;C1[r]-=dl;} \
        const float f=__builtin_amdgcn_exp2f(-dl); l_reg*=f; if(hi==0)wsf[r32]=f; resc=true; } } \
    SBAR(); \
    GAPB(o[0]=__builtin_amdgcn_mfma_f32_32x32x16_bf16(PAF(0),VFR(0),o[0],0,0,0), C0,0); \
    GAPB(o[1]=__builtin_amdgcn_mfma_f32_32x32x16_bf16(PAF(0),VFR(4),o[1],0,0,0), C0,4); \
    KRD(GL,0); GAPB(o[0]=__builtin_amdgcn_mfma_f32_32x32x16_bf16(PAF(1),VFR(1),o[0],0,0,0), C0,8); \
    KRD(GL,1); GAPB(o[1]=__builtin_amdgcn_mfma_f32_32x32x16_bf16(PAF(1),VFR(5),o[1],0,0,0), C0,12); \
    KRD(GL,2); GAPB(o[0]=__builtin_amdgcn_mfma_f32_32x32x16_bf16(PAF(2),VFR(2),o[0],0,0,0), C1,0); \
    KRD(GL,3); GAPB(o[1]=__builtin_amdgcn_mfma_f32_32x32x16_bf16(PAF(2),VFR(6),o[1],0,0,0), C1,4); \
    GAPB(o[0]=__builtin_amdgcn_mfma_f32_32x32x16_bf16(PAF(3),VFR(3),o[0],0,0,0), C1,8); \
    GAPB(o[1]=__builtin_amdgcn_mfma_f32_32x32x16_bf16(PAF(3),VFR(7),o[1],0,0,0), C1,12); \
    }while(0)
  int t=1;
  #undef CMASK
  #define CMASK(P0,P1,t) do{}while(0)
  for(;t+5<NT;t+=2){
    STEP(pB0,pB1,pA0,pA1,t,true,true,true);     WAIT_BAR(2); RESC(); ROT();
    STEP(pA0,pA1,pB0,pB1,t+1,true,true,true);   WAIT_BAR(2); RESC(); ROT();
  }
  #undef CMASK
  #define CMASK(P0,P1,t) do{int jb_=(t)-(NT-4); if(jb_>=0)cmask(P0,P1,jb_,qrel,hi);}while(0)
  #define ENDW(tt) do{ if((tt)+3<NT){WAIT_BAR(2);} else if((tt)+2<NT){WAIT_BAR(1);} else {WAIT_BAR(0);} }while(0)
  for(;t+1<NT;t+=2){
    STEP(pB0,pB1,pA0,pA1,t,(t+3<NT),(t+1<NT),(t+1<NT));       ENDW(t);   RESC(); ROT();
    STEP(pA0,pA1,pB0,pB1,t+1,(t+4<NT),(t+2<NT),(t+2<NT));     ENDW(t+1); RESC(); ROT();
  }
  STEP(pB0,pB1,pA0,pA1,NT-1,false,false,false); RESC();
  { float sacc=pB0[0]+pB0[1]; _Pragma("unroll") for(int r=2;r<16;++r)sacc+=pB0[r]; _Pragma("unroll") for(int r=0;r<16;++r)sacc+=pB1[r]; l_reg+=sacc;
    pw0=(u32x4){PKW(pB0,0),PKW(pB0,2),PKW(pB0,4),PKW(pB0,6)};pw1=(u32x4){PKW(pB0,8),PKW(pB0,10),PKW(pB0,12),PKW(pB0,14)};pw2=(u32x4){PKW(pB1,0),PKW(pB1,2),PKW(pB1,4),PKW(pB1,6)};pw3=(u32x4){PKW(pB1,8),PKW(pB1,10),PKW(pB1,12),PKW(pB1,14)};
    SBAR(); pv(o,vb0+sl_cur,PAF(0),PAF(1),PAF(2),PAF(3)); }
  #undef PKW
  #undef PAF
  #undef VFR
  #undef PIN
  #undef MX3
  #undef GAPA
  #undef GAPB
  #undef EX
  #undef VRD
  #undef KRD
  #undef STEP
  #undef ENDW
  {auto rr=__builtin_amdgcn_permlane32_swap(__float_as_uint(l_reg),__float_as_uint(l_reg),false,false);l_reg=__uint_as_float(rr[0])+__uint_as_float(rr[1]);}
  if(hi==0)wsf[32+r32]=l_reg;asm volatile("s_waitcnt lgkmcnt(0)":::"memory");
  float rli[16];
  #pragma unroll
  for(int r=0;r<16;++r)rli[r]=__builtin_amdgcn_rcpf(wsf[32+crow(r,hi)]);
  bf16*Ow=O+(rowbase+q0+wid*QBLK)*DM+h*D;
  { bf16*stg=(bf16*)(shm+LDS_OST)+wid*2048;
    #pragma unroll
    for(int r=0;r<16;++r){const int orow=crow(r,hi);
      #pragma unroll
      for(int d0=0;d0<2;++d0)stg[orow*64+d0*32+r32]=__float2bfloat16(o[d0][r]*rli[r]);}
    asm volatile("s_waitcnt lgkmcnt(0)":::"memory");
    #pragma unroll
    for(int i=0;i<4;++i){const int row=i*8+(lane>>3),ch=lane&7; const u32x4 v=*(const u32x4*)(stg+row*64+ch*8); ATTN_STORE16(Ow+(long)row*DM+ch*8,v);} }
  asm volatile("s_waitcnt lgkmcnt(0)\n\ts_barrier":::"memory");
  #undef BLOAD
  #undef BLOAD1
  #undef BSUB16
  #undef DMA_K
  #undef DMA_V
  #undef CMASK
  #undef START
  #undef RESC
  #undef ROT
}
constexpr int ATTN_LDS_BYTES=LDS_BYTES;
#undef SBAR
#undef WAIT_BAR
}

#define LAS __attribute__((address_space(3)))
typedef unsigned short bfu;
typedef float f32x4 __attribute__((ext_vector_type(4)));
typedef unsigned v4u __attribute__((ext_vector_type(4)));
typedef unsigned v2u __attribute__((ext_vector_type(2)));
typedef short bf16x8 __attribute__((ext_vector_type(8)));
constexpr int NB = 16, SEQ = 2048, DM = 1024, MTOK = NB * SEQ, FF = 2816, NLAYER = 2, DIN = 7184, NZ = 21 * 256;
constexpr size_t MiB = 1u << 20;
constexpr size_t WO_UP1 = 0, WO_DN1 = WO_UP1 + (size_t)5632 * 1024, WO_IN = WO_DN1 + (size_t)1024 * 2816, WO_GATE = WO_IN + (size_t)NZ * 1024, WO_LRU = WO_GATE + (size_t)2048 * 1024,
                 WO_ATT = WO_LRU + (size_t)1024 * 1024, WO_O = WO_ATT + (size_t)1024 * 1024, WO_UP2 = WO_O + (size_t)1024 * 1024, WO_DN2 = WO_UP2 + (size_t)5632 * 1024, WL_ELEMS = WO_DN2 + (size_t)1024 * 2816;
constexpr size_t WS_RSQ = 0, WS_W = 4 * MiB, WS_XB = 112 * MiB, WS_LOGF = 176 * MiB, WS_ZLX = 178 * MiB, WS_G = 242 * MiB, WS_Q = 306 * MiB, WS_K = 370 * MiB, WS_V = 434 * MiB, WS_END = 498 * MiB;
constexpr size_t WS_ACT = WS_ZLX; constexpr size_t WS_RSTD2 = 111 * MiB + 512 * 1024, WS_BAR = 111 * MiB + 768 * 1024, BAR_BYTES = 16384;
static_assert(WS_W + 2 * WL_ELEMS * 2 <= WS_RSTD2 && WS_RSTD2 + MTOK * 4 <= WS_XB && MTOK == pg8::RSQ_ROWS && WS_W + 2 * WL_ELEMS * 2 <= WS_XB && (size_t)MTOK * FF * 2 <= WS_K - WS_ZLX, "workspace map");
constexpr int LDS_BYTES = 147456;

__device__ __forceinline__ unsigned f2bf(float f) { unsigned u = __builtin_bit_cast(unsigned, f); return (u + 0x7fffu + ((u >> 16) & 1u)) >> 16; }
__device__ __forceinline__ unsigned pk2(float lo, float hi) { return f2bf(lo) | (f2bf(hi) << 16); }
__device__ __forceinline__ float bf2f(unsigned short h) { return __uint_as_float((unsigned)h << 16); }
#define LDS_WAIT() asm volatile("s_waitcnt lgkmcnt(0)" ::: "memory")

__device__ __forceinline__ void tr_item64(const float* W, int N, int K, int k0, int srcA, int nvA, int srcB, int nvB, const float* g, bfu* WT, int dst_row0, LAS float* scr, int lane) {
    const int h = (lane >> 3) & 1, c4 = 4 * (lane & 7); const bool ok = c4 < (h ? nvB : nvA);
    const float* wp = W + (size_t)(k0 + (lane >> 4)) * N + (h ? srcB : srcA) + c4; const float* gp = g ? g + k0 + (lane >> 4) : nullptr;
    LAS float* sp = scr + (lane >> 4) * 65 + 32 * h + c4;
#pragma unroll 8
    for (int i = 0; i < 16; ++i) { f32x4 v = {0.f, 0.f, 0.f, 0.f}; if (ok) v = *(const f32x4*)(wp + (size_t)(4 * i) * N); if (gp) v = v * gp[4 * i];
        sp[(4 * i) * 65 + 0] = v[0]; sp[(4 * i) * 65 + 1] = v[1]; sp[(4 * i) * 65 + 2] = v[2]; sp[(4 * i) * 65 + 3] = v[3]; }
    LDS_WAIT(); asm volatile("" ::: "memory");
    const int c = lane & 7;
#pragma unroll
    for (int q = 0; q < 8; ++q) { const int n = 8 * q + (lane >> 3); const LAS float* s = scr + (8 * c) * 65 + n;
        v4u o; o.x = pk2(s[0 * 65], s[1 * 65]); o.y = pk2(s[2 * 65], s[3 * 65]); o.z = pk2(s[4 * 65], s[5 * 65]); o.w = pk2(s[6 * 65], s[7 * 65]);
        *(v4u*)(WT + (size_t)(dst_row0 + n) * K + k0 + 8 * c) = o; }
    LDS_WAIT(); asm volatile("" ::: "memory");
}
__device__ __forceinline__ void win_src(int r, int& src, int& nv) { const int pn = r >> 3, r8 = r & 7; nv = 32;
    if (pn < 8) src = 256 * pn + 32 * r8;
    else if (pn < 16) src = 2048 + 256 * (pn - 8) + 64 * (r8 & 3) + 32 * (r8 >> 2);
    else if (pn < 20) src = 4096 + 256 * (pn - 16) + 32 * r8;
    else { src = 5120; nv = (r8 == 0) ? 16 : 0; } }
__device__ __forceinline__ int up_src(int r) { const int pn = r >> 3, r8 = r & 7; return (r8 >> 2) * 2816 + 128 * pn + 32 * (r8 & 3); }
struct Args { const float* in[23]; float* out; unsigned char* ws; };

typedef const __attribute__((address_space(4))) Args* kargs_t;
__device__ __forceinline__ void prologue(kargs_t a, LAS unsigned char* lds, int gw, int NGW, int wave, int lane) {
    LAS float* scr = (LAS float*)(lds + wave * 16640);
    constexpr int I_UP = 88 * 16, I_DN = 16 * 44, I_IN = 84 * 16, I_GT = 32 * 16, I_SQ = 16 * 16;
    constexpr int I_LAYER = 2 * I_UP + 2 * I_DN + I_IN + I_GT + 3 * I_SQ;
    for (int it = gw; it < NLAYER * I_LAYER; it += NGW) {
        const int l = it / I_LAYER; int r = it - l * I_LAYER;
        bfu* WL = (bfu*)(a->ws + WS_W) + (size_t)l * WL_ELEMS;
        if (r < 2 * I_UP) { const int second = r >= I_UP; if (second) r -= I_UP;
            const int kb = r / 88, nb = r - kb * 88;
            tr_item64(a->in[second ? 21 : 2] + (size_t)l * 1024 * 5632, 5632, 1024, kb * 64, up_src(2 * nb), 32, up_src(2 * nb + 1), 32, a->in[second ? 20 : 1] + l * 1024, WL + (second ? WO_UP2 : WO_UP1), nb * 64, scr, lane); continue; }
        r -= 2 * I_UP;
        if (r < 2 * I_DN) { const int second = r >= I_DN; if (second) r -= I_DN;
            const int kb = r >> 4, nb = r & 15;
            tr_item64(a->in[second ? 22 : 3] + (size_t)l * 2816 * 1024, 1024, 2816, kb * 64, nb * 64, 32, nb * 64 + 32, 32, nullptr, WL + (second ? WO_DN2 : WO_DN1), nb * 64, scr, lane); continue; }
        r -= 2 * I_DN;
        if (r < I_IN) { const int kb = r / 84, nb = r - kb * 84; int sA, nA, sB, nB; win_src(2 * nb, sA, nA); win_src(2 * nb + 1, sB, nB);
            tr_item64(a->in[5] + (size_t)l * 1024 * DIN, DIN, 1024, kb * 64, sA, nA, sB, nB, a->in[4] + l * 1024, WL + WO_IN, nb * 64, scr, lane); continue; }
        r -= I_IN;
        if (r < I_GT) { const int kb = r >> 5, nb = r & 31;
            const int gsrc = 5136 + ((nb >> 1) & 1) * 1024 + 128 * (nb >> 2) + 64 * (nb & 1);
            tr_item64(a->in[5] + (size_t)l * 1024 * DIN, DIN, 1024, kb * 64, gsrc, 32, gsrc + 32, 32, a->in[4] + l * 1024, WL + WO_GATE, nb * 64, scr, lane); continue; }
        r -= I_GT;
        { const int w = r / I_SQ; r -= w * I_SQ; const int kb = r >> 4, nb = r & 15;
            tr_item64(a->in[17 + w] + (size_t)l * 1024 * 1024, 1024, 1024, kb * 64, nb * 64, 32, nb * 64 + 32, 32, nullptr, WL + (w == 0 ? WO_LRU : w == 1 ? WO_ATT : WO_O), nb * 64, scr, lane); }
    }
    float* rsq = (float*)(a->ws + WS_RSQ); bfu* xb = (bfu*)(a->ws + WS_XB);
    for (int m0 = 2 * gw; m0 < MTOK; m0 += 2 * NGW) {
        f32x4 v[2][4]; float sq[2];
#pragma unroll
        for (int rr = 0; rr < 2; ++rr) { const f32x4* xr = (const f32x4*)(a->in[0] + (size_t)(m0 + rr) * DM) + lane;
#pragma unroll
            for (int j = 0; j < 4; ++j) v[rr][j] = xr[64 * j]; }
#pragma unroll
        for (int rr = 0; rr < 2; ++rr) { float s = 0.f;
#pragma unroll
            for (int j = 0; j < 4; ++j) s += (v[rr][j][0] * v[rr][j][0] + v[rr][j][1] * v[rr][j][1]) + (v[rr][j][2] * v[rr][j][2] + v[rr][j][3] * v[rr][j][3]);
#pragma unroll
            for (int o = 1; o < 64; o <<= 1) s += pg8::bperm(lane ^ o, s);
            sq[rr] = s; }
#pragma unroll
        for (int rr = 0; rr < 2; ++rr) { const int m = m0 + rr;
            if (lane < 16) rsq[(size_t)m * 16 + lane] = lane == 0 ? sq[rr] : 0.f;
            v2u* o8 = (v2u*)(xb + (size_t)m * DM) + lane;
#pragma unroll
            for (int j = 0; j < 4; ++j) { v2u w; w.x = pk2(v[rr][j][0], v[rr][j][1]); w.y = pk2(v[rr][j][2], v[rr][j][3]); o8[64 * j] = w; } } }
}

constexpr int SC_XA = 0, SC_WT = 17408, SC_XF = 52224, SC_AA = 68608, SC_UU = 84992, SC_SEG = 101376, SC_CAR = 105472, SC_CW = 105984, SC_CH = 108544, SC_GT = 109312, SC_YT = 118528, SC_END = 127744;
__device__ __forceinline__ void scan_item(LAS unsigned char* lds, int b, int n, int hf, const bfu* ZLX, bfu* G, const float* conv_w, const float* conv_b,
                                          const float* w_a, const float* b_a, const float* w_x, const float* b_x, const float* lam, int tid) {
    LAS bfu* XA = (LAS bfu*)(lds + SC_XA); LAS bfu* WT = (LAS bfu*)(lds + SC_WT); LAS float* XF = (LAS float*)(lds + SC_XF); LAS float* AA = (LAS float*)(lds + SC_AA); LAS float* UU = (LAS float*)(lds + SC_UU);
    LAS float* SEG = (LAS float*)(lds + SC_SEG); LAS float* CAR = (LAS float*)(lds + SC_CAR); LAS float* CW = (LAS float*)(lds + SC_CW); LAS float* CH = (LAS float*)(lds + SC_CH);
    LAS bfu* GT = (LAS bfu*)(lds + SC_GT); LAS bfu* YT = (LAS bfu*)(lds + SC_YT);
    const int lane = tid & 63, wave = tid >> 6;
    for (int idx = tid; idx < 128 * 64; idx += 512) { const int c = idx >> 6, dl = idx & 63; const size_t src = ((size_t)n * 128 + c) * 128 + 64 * hf + dl;
        const unsigned pw_ = pg8::cvt_pk_bf16(w_a[src], w_x[src]); WT[dl * 136 + c] = (bfu)(pw_ & 0xffffu); WT[(64 + dl) * 136 + c] = (bfu)(pw_ >> 16); }
    if (tid < 128) { CW[tid] = conv_w[128 * n + tid]; CW[128 + tid] = conv_w[1024 + 128 * n + tid]; CW[256 + tid] = conv_w[2048 + 128 * n + tid]; CW[384 + tid] = conv_w[3072 + 128 * n + tid]; CW[512 + tid] = conv_b[128 * n + tid]; }
    if (tid < 64) { const int d = 128 * n + 64 * hf + tid; CH[tid] = b_a[d]; CH[64 + tid] = b_x[d]; CH[128 + tid] = 8.0f * log1pf(expf(-lam[d])); CAR[tid] = 0.f; }
    __syncthreads();
    const int cg4 = tid & 31, tg = tid >> 5;
    f32x4 cw[4], cb;
#pragma unroll
    for (int k = 0; k < 4; ++k) cw[k] = *(const LAS f32x4*)(CW + 128 * k + 4 * cg4);
    cb = *(const LAS f32x4*)(CW + 512 + 4 * cg4);
    const int tt = wave >> 1, cts = 2 * (wave & 1), l15 = lane & 15, lq = lane >> 4;
    const int sc = tid & 63, sg = tid >> 6;
    bf16x8 wfr[2][2][4];
#pragma unroll
    for (int mt = 0; mt < 2; ++mt)
#pragma unroll
        for (int ci = 0; ci < 2; ++ci)
#pragma unroll
            for (int ks = 0; ks < 4; ++ks) wfr[mt][ci][ks] = *(const LAS bf16x8*)(WT + (64 * mt + 16 * (cts + ci) + l15) * 136 + 32 * ks + 8 * lq);
    const size_t rowb = (size_t)b * SEQ;
    const bfu* zsrc = ZLX + rowb * DM + 128 * n + 4 * cg4;
    v2u xw[7];
#pragma unroll
    for (int i = 0; i < 7; ++i) { const int r = 4 * tg - 3 + i; xw[i] = (v2u){0u, 0u}; if (r >= 0) xw[i] = *(const v2u*)(zsrc + (size_t)r * DM); }
    for (int ch = 0; ch < SEQ / 64; ++ch) {
        const int t0 = ch * 64;
        bfu* gio = G + (rowb + t0 + (tid >> 3)) * DM + 128 * n + 64 * hf + 8 * (tid & 7);
        const v4u gvec = *(const v4u*)gio;
        { f32x4 xr[7];
#pragma unroll
            for (int i = 0; i < 7; ++i) { const v2u w = xw[i];
                xr[i][0] = __uint_as_float(w.x << 16); xr[i][1] = __uint_as_float(w.x & 0xffff0000u); xr[i][2] = __uint_as_float(w.y << 16); xr[i][3] = __uint_as_float(w.y & 0xffff0000u); }
            if (ch + 1 < SEQ / 64) {
#pragma unroll
                for (int i = 0; i < 7; ++i) xw[i] = *(const v2u*)(zsrc + (size_t)(t0 + 64 + 4 * tg - 3 + i) * DM); }
#pragma unroll
            for (int j = 0; j < 4; ++j) { f32x4 y = cb + cw[0] * xr[j] + cw[1] * xr[j + 1] + cw[2] * xr[j + 2] + cw[3] * xr[j + 3];
                v2u w; w.x = pg8::cvt_pk_bf16(y[0], y[1]); w.y = pg8::cvt_pk_bf16(y[2], y[3]); *(LAS v2u*)(XA + (4 * tg + j) * 136 + 4 * cg4) = w;
                if ((cg4 >> 4) == hf) *(LAS f32x4*)(XF + (4 * tg + j) * 64 + 4 * (cg4 & 15)) = y; } }
        __syncthreads();
        *(LAS v4u*)(GT + (tid >> 3) * 64 + 8 * (tid & 7)) = gvec;
        if (ch > 0) *(v4u*)(gio - (size_t)64 * DM) = *(const LAS v4u*)(YT + (tid >> 3) * 64 + 8 * (tid & 7));
        { f32x4 acc[2][2];
#pragma unroll
            for (int mt = 0; mt < 2; ++mt)
#pragma unroll
                for (int ci = 0; ci < 2; ++ci) acc[mt][ci] = (f32x4){0.f, 0.f, 0.f, 0.f};
#pragma unroll
            for (int ks = 0; ks < 4; ++ks) { const bf16x8 af = *(const LAS bf16x8*)(XA + (16 * tt + l15) * 136 + 32 * ks + 8 * lq);
#pragma unroll
                for (int mt = 0; mt < 2; ++mt)
#pragma unroll
                    for (int ci = 0; ci < 2; ++ci) acc[mt][ci] = __builtin_amdgcn_mfma_f32_16x16x32_bf16(af, wfr[mt][ci][ks], acc[mt][ci], 0, 0, 0); }
#pragma unroll
            for (int ci = 0; ci < 2; ++ci) { const int d = 16 * (cts + ci) + l15; const float ba = CH[d], bx = CH[64 + d], sp8 = CH[128 + d];
#pragma unroll
                for (int j = 0; j < 4; ++j) { const int tok = 16 * tt + 4 * lq + j;
                    const float r = pg8::sigm(acc[0][ci][j] + ba), ig = pg8::sigm(acc[1][ci][j] + bx);
                    const float la = -sp8 * r, av = __builtin_amdgcn_exp2f(pg8::kLog2e * la);
                    const float om = __builtin_fmaf(-av, av, 1.0f);
                    AA[tok * 64 + d] = av; UU[tok * 64 + d] = __builtin_sqrtf(om) * ig * XF[tok * 64 + d]; } } }
        __syncthreads();
        { float av[8], uv[8];
#pragma unroll
            for (int k = 0; k < 8; ++k) { av[k] = AA[(8 * sg + k) * 64 + sc]; uv[k] = UU[(8 * sg + k) * 64 + sc]; }
            float P = 1.f, H = 0.f;
#pragma unroll
            for (int k = 0; k < 8; ++k) { H = av[k] * H + uv[k]; P *= av[k]; }
            SEG[(sg * 64 + sc) * 2] = P; SEG[(sg * 64 + sc) * 2 + 1] = H;
            __syncthreads();
            float h = CAR[(ch & 1) * 64 + sc];
            { float sp_[7], sh_[7];
#pragma unroll
              for (int s = 0; s < 7; ++s) { sp_[s] = SEG[(s * 64 + sc) * 2]; sh_[s] = SEG[(s * 64 + sc) * 2 + 1]; }
#pragma unroll
              for (int s = 0; s < 7; ++s) h = (s < sg) ? sp_[s] * h + sh_[s] : h; }
#pragma unroll
            for (int k = 0; k < 8; ++k) { h = av[k] * h + uv[k]; YT[(8 * sg + k) * 64 + sc] = (bfu)(pg8::cvt_pk_bf16(bf2f(GT[(8 * sg + k) * 64 + sc]) * h, 0.f) & 0xffffu); }
            if (sg == 7) CAR[((ch + 1) & 1) * 64 + sc] = h; }
    }
    __syncthreads();
    *(v4u*)(G + (rowb + SEQ - 64 + (tid >> 3)) * DM + 128 * n + 64 * hf + 8 * (tid & 7)) = *(const LAS v4u*)(YT + (tid >> 3) * 64 + 8 * (tid & 7));
    __syncthreads();
}

__device__ __forceinline__ void forget_phase(const bfu* xb, const bfu* wf  , const float* rowsq, const float* bforget, float* logf, float* rstd2, int bx, int G, int tid) {
    const int lane = tid & 63, wave = tid >> 6, l15 = lane & 15, lq = lane >> 4;
    for (int blk = bx * 8 + wave; blk < MTOK / 16; blk += G * 8) {
        const int row0 = blk * 16;
        const bfu* ap = xb + (size_t)(row0 + l15) * DM + 8 * lq; const bfu* bp = wf + (size_t)l15 * DM + 8 * lq;
        f32x4 acc = {0.f, 0.f, 0.f, 0.f};
#pragma unroll 8
        for (int ks = 0; ks < 32; ++ks) { const bf16x8 af = *(const bf16x8*)(ap + 32 * ks), bfv = *(const bf16x8*)(bp + 32 * ks); acc = __builtin_amdgcn_mfma_f32_16x16x32_bf16(af, bfv, acc, 0, 0, 0); }
        const float bf = bforget[l15];
#pragma unroll
        for (int j = 0; j < 4; ++j) { const int row = row0 + 4 * lq + j; const f32x4* pp = (const f32x4*)(rowsq + (size_t)row * 16);
            const f32x4 p0 = pp[0], p1 = pp[1], p2 = pp[2], p3 = pp[3];
            const float ssum = ((p0[0] + p0[1]) + (p0[2] + p0[3])) + ((p1[0] + p1[1]) + (p1[2] + p1[3])) + ((p2[0] + p2[1]) + (p2[2] + p2[3])) + ((p3[0] + p3[1]) + (p3[2] + p3[3]));
            const float rs = __builtin_amdgcn_rsqf(ssum * (1.0f / 1024.0f) + 1e-6f);
            const float x = acc[j] * rs + bf;
            logf[(size_t)row * 16 + l15] = fminf(x, 0.f) - log1pf(__expf(-fabsf(x)));
            if (l15 == 0) rstd2[row] = rs; }
    }
}
constexpr int ATT_TBL_BYTES = (SEQ + 64) * 4, ATT_SCR_OFF = attn_body::LDS_NB + 2 * ATT_TBL_BYTES;
__device__ __forceinline__ void bias_table(LAS unsigned char* lds, const float* logf, const float* gq, const float* gk, int b, int h, int tid, int tbl) {
    LAS float* nb = (LAS float*)(lds + attn_body::LDS_NB + tbl * ATT_TBL_BYTES); LAS float* wsum = (LAS float*)(lds + ATT_SCR_OFF);
    const int lane = tid & 63, wave = tid >> 6;
    const float* p = logf + ((size_t)b * SEQ + 4 * tid) * 16 + h;
    float v0 = p[0], v1 = p[16], v2 = p[32], v3 = p[48];
    v1 += v0; v2 += v1; v3 += v2;
    float s = v3;
#pragma unroll
    for (int o = 1; o < 64; o <<= 1) { const float t = pg8::bperm(lane - o, s); if (lane >= o) s += t; }
    if (lane == 63) wsum[wave] = s;
    __syncthreads();
    float off = s - v3;
    for (int w = 0; w < wave; ++w) off += wsum[w];
    const float k = -pg8::kLog2e;
    *(LAS f32x4*)(nb + 4 * tid) = (f32x4){(off + v0) * k, (off + v1) * k, (off + v2) * k, (off + v3) * k};
    if (tid < 64) { nb[SEQ + tid] = 0.f;
        float mq = fabsf(gq[tid]), mk = fabsf(gk[tid]);
#pragma unroll
        for (int o = 1; o < 64; o <<= 1) { mq = fmaxf(mq, pg8::bperm(lane ^ o, mq)); mk = fmaxf(mk, pg8::bperm(lane ^ o, mk)); }
        if (tid == 0) wsum[8] = attn_body::C2 * 64.0f * mq * mk; }
    __syncthreads();
}

#define GRID_SYNC_CG() do { asm volatile("s_waitcnt vmcnt(0) lgkmcnt(0)" ::: "memory"); grid.sync(); } while (0)
#define GRID_SYNC() do { kargs_t apb_ = (kargs_t)__builtin_amdgcn_kernarg_segment_ptr(); asm volatile("" : "+s"(apb_)); XcdBarrier xb_; xb_.bar = (unsigned*)(apb_->ws + WS_BAR); xb_.x = xb_xcc_id(); xb_.st = (volatile LAS unsigned*)(lds + (LDS_BYTES - 64)); \
    TID_NOW(tb_); xcd_barrier(xb_, tb_ == 0); } while (0)
#define PHASE_ARGS() kargs_t ap = (kargs_t)__builtin_amdgcn_kernarg_segment_ptr(); asm volatile("" : "+s"(ap)); unsigned char* const ws = ap->ws; (void)ws

#define RLX_AGENT __ATOMIC_RELAXED, __HIP_MEMORY_SCOPE_AGENT
#define XB_TMO      128
#define XB_XCNT(j)  (256  + 64 * (j))
#define XB_XSUB(j)  (1280 + 64 * (j))
#define XB_XGEN(j)  (2304 + 64 * (j))
#define XB_TOP      3328
#define XB_TOPGEN   3392
#define XCD_BAR_WORDS 3456
#define XB_SPIN_CAP (1u << 18)

__device__ __forceinline__ unsigned xb_ld(unsigned* p)              { return __hip_atomic_load(p, __ATOMIC_RELAXED, __HIP_MEMORY_SCOPE_AGENT); }
__device__ __forceinline__ unsigned xb_add(unsigned* p, unsigned v) { return __hip_atomic_fetch_add(p, v, __ATOMIC_RELAXED, __HIP_MEMORY_SCOPE_AGENT); }
__device__ __forceinline__ unsigned xb_xcc_id() { return (unsigned)__builtin_amdgcn_s_getreg((3 << 11) | 20) & 0xFu; }
#define XB_SPIN(cond, bar) do { unsigned _sp = 0; while (cond) { __builtin_amdgcn_s_sleep(1); \
    if ((++_sp & 255u) == 0u) { if (xb_ld(&(bar)[XB_TMO])) break; if (_sp > XB_SPIN_CAP) { atomicAdd(&(bar)[XB_TMO], 1u); break; } } } } while (0)

struct XcdBarrier {
    unsigned* bar; unsigned x;
    volatile LAS unsigned* st;
};

__device__ __forceinline__ XcdBarrier xcd_barrier_post(unsigned* bar, volatile LAS unsigned* st, bool leader) {
    XcdBarrier b; b.bar = bar; b.x = xb_xcc_id(); b.st = st;
    if (leader) (void)xb_add(&bar[XB_XCNT(b.x)], 1u);
    return b;
}
__device__ __forceinline__ void xcd_barrier_complete(unsigned* bar, unsigned x, unsigned& nloc, unsigned& nx) {
    const unsigned G = gridDim.x * gridDim.y * gridDim.z;
    unsigned sum, cnt, mine, sp = 0u;
    for (;;) {
        sum = 0u; cnt = 0u; mine = 0u;
#pragma unroll
        for (unsigned j = 0; j < 16; ++j) { const unsigned c = xb_ld(&bar[XB_XCNT(j)]); sum += c; cnt += (c > 0u) ? 1u : 0u; mine = (j == x) ? c : mine; }
        if (sum == G) break;
        __builtin_amdgcn_s_sleep(1);
        if ((++sp & 255u) == 0u) { if (xb_ld(&bar[XB_TMO])) break; if (sp > XB_SPIN_CAP) { atomicAdd(&bar[XB_TMO], 1u); break; } }
    }
    nloc = mine > 0u ? mine : 1u; nx = cnt > 0u ? cnt : 1u;
}

__device__ __forceinline__ void xcd_barrier(const XcdBarrier& b, bool leader) {
    asm volatile("s_waitcnt vmcnt(0)" ::: "memory");
    __syncthreads();
    if (leader) {
        unsigned* bar = b.bar;
        __builtin_amdgcn_s_waitcnt(0);
        unsigned nloc = b.st[0], nx = b.st[1];
        if (nloc == 0u) { xcd_barrier_complete(bar, b.x, nloc, nx); b.st[0] = nloc; b.st[1] = nx; }
        const unsigned old = xb_add(&bar[XB_XSUB(b.x)], 1u);
        const unsigned gen = old / nloc;
        if (old + 1u == (gen + 1u) * nloc) {
            __builtin_amdgcn_fence(__ATOMIC_RELEASE, "agent");
            asm volatile("s_waitcnt vmcnt(0)" ::: "memory");
            const unsigned og = xb_add(&bar[XB_TOP], 1u);
            const unsigned tg = og / nx;
            if (og + 1u == (tg + 1u) * nx) xb_add(&bar[XB_TOPGEN], 1u);
            else XB_SPIN(xb_ld(&bar[XB_TOPGEN]) == tg, bar);
            __builtin_amdgcn_fence(__ATOMIC_ACQUIRE, "agent");
            xb_add(&bar[XB_XGEN(b.x)], 1u);
            asm volatile("s_waitcnt vmcnt(0)" ::: "memory");
        } else {
            XB_SPIN(xb_ld(&bar[XB_XGEN(b.x)]) == gen, bar);
            __builtin_amdgcn_fence(__ATOMIC_ACQUIRE, "agent");
            asm volatile("s_waitcnt vmcnt(0)" ::: "memory");
        }
    }
    __syncthreads();
}

#ifdef DBG_STOP
#define DBG_AT(k, buf) do { if (DBG_STOP == (k) && l == 0) { GRID_SYNC(); PHASE_ARGS(); const bfu* src_ = (const bfu*)(ws + (buf)); float* o_ = ap->out; \
    TID_NOW(tid_); for (size_t i_ = (size_t)bx * 512 + tid_; i_ < (size_t)MTOK * DM; i_ += (size_t)G * 512) o_[i_] = bf2f(src_[i_]); return; } } while (0)
#define DBG_ATF(k, buf) do { if (DBG_STOP == (k) && l == 0) { GRID_SYNC(); PHASE_ARGS(); const float* src_ = (const float*)(ws + (buf)); float* o_ = ap->out; \
    TID_NOW(tid_); for (size_t i_ = (size_t)bx * 512 + tid_; i_ < (size_t)MTOK * DM; i_ += (size_t)G * 512) o_[i_] = src_[i_ >> 10]; return; } } while (0)
#else
#define DBG_ATF(k, buf) do {} while (0)
#define DBG_AT(k, buf) do {} while (0)
#endif
__global__ void __launch_bounds__(512, 2) fwd_megakernel(Args a_unused) {
    extern __shared__ __attribute__((aligned(16))) unsigned char lds_raw[];
    cg::grid_group grid = cg::this_grid();
    LAS unsigned char* lds = (LAS unsigned char*)lds_raw;
    const int wave_s = __builtin_amdgcn_readfirstlane((int)threadIdx.x >> 6);
#define TID_NOW(v) int v; asm volatile("v_mbcnt_lo_u32_b32 %0, -1, 0\n\tv_mbcnt_hi_u32_b32 %0, -1, %0" : "=v"(v)); v += wave_s * 64
    const int G = gridDim.x, bx = blockIdx.x;

    { TID_NOW(t0_); if (t0_ < 2) ((volatile LAS unsigned*)(lds + (LDS_BYTES - 64)))[t0_] = 0u; __syncthreads();
      kargs_t apb_ = (kargs_t)__builtin_amdgcn_kernarg_segment_ptr(); (void)xcd_barrier_post((unsigned*)(apb_->ws + WS_BAR), (volatile LAS unsigned*)(lds + (LDS_BYTES - 64)), t0_ == 0); }
    { PHASE_ARGS(); TID_NOW(tl); prologue(ap, lds, bx * 8 + (tl >> 6), G * 8, tl >> 6, tl & 63); }
    if (G == 0x7fffffff) grid.sync();
    GRID_SYNC();

    for (int ph = 0; ph < 9 * NLAYER; ++ph) { const int l = ph / 9, sub = ph - 9 * l;
        if (sub == 0) {
        { PHASE_ARGS(); TID_NOW(tl); const bfu* WL = (const bfu*)(ws + WS_W) + (size_t)l * WL_ELEMS; const bfu* xb = (const bfu*)(ws + WS_XB);
          pg8::Gemm g{xb, xb, xb, xb, WL + WO_UP1, WL + WO_UP1, WL + WO_UP1, WL + WO_UP1, 1024}; pg8::StaticOrder S; S.init(MTOK, 5632, G, bx, 1);
          pg8::EpiUp E{(bfu*)(ws + WS_ACT), (const float*)(ws + WS_RSQ) + (size_t)((3 * l) & 1) * 16 * MTOK};
          pg8::gemm_phase<pg8::EpiUp, pg8::StaticOrder, true, true>(lds, g, S, E, tl); }
        } else if (sub == 1) {
        { PHASE_ARGS(); TID_NOW(tl); const bfu* WL = (const bfu*)(ws + WS_W) + (size_t)l * WL_ELEMS; const bfu* act = (const bfu*)(ws + WS_ACT);
          pg8::Gemm g{act, act, act, act, WL + WO_DN1, WL + WO_DN1, WL + WO_DN1, WL + WO_DN1, 2816}; pg8::StaticOrder S; S.init(MTOK, 1024, G, bx, 1);
          pg8::EpiRes E{l == 0 ? ap->in[0] : nullptr, (const bfu*)ap->out, nullptr, (bfu*)ap->out, (bfu*)(ws + WS_XB), (float*)(ws + WS_RSQ) + (size_t)((3 * l + 1) & 1) * 16 * MTOK, 0.5f};
          pg8::gemm_phase<pg8::EpiRes, pg8::StaticOrder, true, true>(lds, g, S, E, tl); }
        } else if (sub == 2) {
        { PHASE_ARGS(); TID_NOW(tl); const bfu* WL = (const bfu*)(ws + WS_W) + (size_t)l * WL_ELEMS; const bfu* xb = (const bfu*)(ws + WS_XB);
          pg8::Gemm g{xb, xb, xb, xb, WL + WO_IN, WL + WO_IN, WL + WO_IN, WL + WO_IN, 1024}; pg8::StaticOrder S; S.init(MTOK, NZ - 256, G, bx, 1);
          pg8::EpiZ E{(bfu*)(ws + WS_ZLX), (bfu*)(ws + WS_G), (bfu*)(ws + WS_Q), (bfu*)(ws + WS_K), (bfu*)(ws + WS_V), (float*)(ws + WS_LOGF), (const float*)(ws + WS_RSQ) + (size_t)((3 * l + 1) & 1) * 16 * MTOK,
                      ap->in[14] + l * 64, ap->in[15] + l * 64, ap->in[16] + l * 16, attn_body::C2, (float*)(ws + WS_RSTD2)};
          pg8::gemm_phase<pg8::EpiZ, pg8::StaticOrder, true, true>(lds, g, S, E, tl); }
        } else if (sub == 3) {
        { PHASE_ARGS(); TID_NOW(tl); const bfu* WL = (const bfu*)(ws + WS_W) + (size_t)l * WL_ELEMS;
          forget_phase((const bfu*)(ws + WS_XB), WL + WO_IN + (size_t)5120 * 1024, (const float*)(ws + WS_RSQ) + (size_t)((3 * l + 1) & 1) * 16 * MTOK, ap->in[16] + l * 16, (float*)(ws + WS_LOGF), (float*)(ws + WS_RSTD2), bx, G, tl); }
        } else if (sub == 4) {
        { PHASE_ARGS();
          for (int grp = bx; grp < NB * 16; grp += G) {
            TID_NOW(tl);
            const int b = grp >> 4, p = (grp & 15) >> 1, side = grp & 1;
            const float* bfp = ap->in[16] + l * 16;
            int hA = 0, hB = 0;
            for (int h = 0; h < 16; ++h) { const float v = bfp[h]; int rk = 0;
                for (int j = 0; j < 16; ++j) { const float w = bfp[j]; rk += (w > v || (w == v && j < h)) ? 1 : 0; }
                if (rk == p) hA = h; if (rk == 15 - p) hB = h; }
            bias_table(lds, (const float*)(ws + WS_LOGF), ap->in[14] + l * 64, ap->in[15] + l * 64, b, hA, tl, 0);
            bias_table(lds, (const float*)(ws + WS_LOGF), ap->in[14] + l * 64, ap->in[15] + l * 64, b, hB, tl, 1);
            const float qkmax = __builtin_bit_cast(float, __builtin_amdgcn_readfirstlane(__builtin_bit_cast(int, ((const LAS float*)(lds + ATT_SCR_OFF))[8])));
            unsigned long long tspack = 0ull; unsigned mine = 0u; int load0 = 0, load1 = 0;
            for (int u = 0; u < 16; ++u) { const int hs = u >> 3, qb = 7 - (u & 7);
                const LAS float* nbL = (const LAS float*)(lds + attn_body::LDS_NB + hs * ATT_TBL_BYTES);
                const float lim = __builtin_bit_cast(float, __builtin_amdgcn_readfirstlane(__builtin_bit_cast(int, nbL[256 * qb]))) - (2.0f * qkmax + 40.0f);
                int ts = 0;
                while (ts + 2 <= 4 * qb && __builtin_bit_cast(float, __builtin_amdgcn_readfirstlane(__builtin_bit_cast(int, nbL[64 * (ts + 1) + 63]))) < lim) ts += 2;
                const int cost = (4 * qb + 4 - ts) + 4;
                const int owner = (load0 <= load1) ? 0 : 1; if (owner == 0) load0 += cost; else load1 += cost;
                if (owner == side) mine |= 1u << u;
                tspack |= (unsigned long long)(ts >> 1) << (4 * u); }
            for (int u = 0; u < 16; ++u) { if (!((mine >> u) & 1u)) continue;
                const int hs = u >> 3, qb = 7 - (u & 7), ts = (int)((tspack >> (4 * u)) & 15ull) * 2;
                attn_body::attn_unit<64>(b, hs ? hB : hA, qb, (const attn_body::bf16*)(ws + WS_Q), (const attn_body::bf16*)(ws + WS_K), (const attn_body::bf16*)(ws + WS_V), (attn_body::bf16*)(ws + WS_Q), (char*)lds_raw, tl, ts, hs * ATT_TBL_BYTES); }
            __syncthreads();
          }
        }
        { PHASE_ARGS();
          for (int it = bx; it < NB * 16; it += G) { TID_NOW(tl);
            scan_item(lds, it >> 4, (it >> 1) & 7, it & 1, (const bfu*)(ws + WS_ZLX), (bfu*)(ws + WS_G), ap->in[7] + (size_t)l * 4096, ap->in[8] + l * 1024, ap->in[9] + (size_t)l * 131072, ap->in[10] + l * 1024,
                      ap->in[11] + (size_t)l * 131072, ap->in[12] + l * 1024, ap->in[13] + l * 1024, tl); } }
        } else if (sub == 5) {
        { PHASE_ARGS(); TID_NOW(tl); const bfu* WL = (const bfu*)(ws + WS_W) + (size_t)l * WL_ELEMS; const bfu* xb = (const bfu*)(ws + WS_XB);
          pg8::Gemm g{(const bfu*)(ws + WS_G), (const bfu*)(ws + WS_Q), xb, xb, WL + WO_LRU, WL + WO_ATT, WL + WO_GATE, WL + WO_GATE, 1024}; pg8::StaticOrder S; S.init(MTOK, 1024, G, bx, 4, 1);
          pg8::EpiMerge E{(bfu*)(ws + WS_K), (bfu*)(ws + WS_V), (bfu*)(ws + WS_ZLX), (const float*)(ws + WS_RSTD2), ap->in[6] + l * 2048};
          pg8::gemm_phase<pg8::EpiMerge, pg8::StaticOrder, true, true>(lds, g, S, E, tl); }
        } else if (sub == 6) {
        { PHASE_ARGS(); TID_NOW(tl); const bfu* WL = (const bfu*)(ws + WS_W) + (size_t)l * WL_ELEMS; const bfu* mb = (const bfu*)(ws + WS_ZLX);
          pg8::Gemm g{mb, mb, mb, mb, WL + WO_O, WL + WO_O, WL + WO_O, WL + WO_O, 1024}; pg8::StaticOrder S; S.init(MTOK, 1024, G, bx, 1);
          pg8::EpiRes E{nullptr, (const bfu*)ap->out, nullptr, (l + 1 < NLAYER) ? (bfu*)ap->out : (bfu*)(ws + WS_K), (bfu*)(ws + WS_XB), (float*)(ws + WS_RSQ) + (size_t)((3 * l + 2) & 1) * 16 * MTOK, 1.0f};
          pg8::gemm_phase<pg8::EpiRes, pg8::StaticOrder, true, true>(lds, g, S, E, tl); }
        } else if (sub == 7) {
        { PHASE_ARGS(); TID_NOW(tl); const bfu* WL = (const bfu*)(ws + WS_W) + (size_t)l * WL_ELEMS; const bfu* xb = (const bfu*)(ws + WS_XB);
          pg8::Gemm g{xb, xb, xb, xb, WL + WO_UP2, WL + WO_UP2, WL + WO_UP2, WL + WO_UP2, 1024}; pg8::StaticOrder S; S.init(MTOK, 5632, G, bx, 1);
          pg8::EpiUp E{(bfu*)(ws + WS_ACT), (const float*)(ws + WS_RSQ) + (size_t)((3 * l + 2) & 1) * 16 * MTOK};
          pg8::gemm_phase<pg8::EpiUp, pg8::StaticOrder, true, true>(lds, g, S, E, tl); }
        } else {
        { PHASE_ARGS(); TID_NOW(tl); const bfu* WL = (const bfu*)(ws + WS_W) + (size_t)l * WL_ELEMS; const bfu* act = (const bfu*)(ws + WS_ACT);
          const bool more = (l + 1 < NLAYER);
          pg8::Gemm g{act, act, act, act, WL + WO_DN2, WL + WO_DN2, WL + WO_DN2, WL + WO_DN2, 2816}; pg8::StaticOrder S; S.init(MTOK, 1024, G, bx, 1);
          pg8::EpiRes E{nullptr, more ? (const bfu*)ap->out : (const bfu*)(ws + WS_K), more ? nullptr : ap->out, more ? (bfu*)ap->out : nullptr, more ? (bfu*)(ws + WS_XB) : nullptr, more ? (float*)(ws + WS_RSQ) + (size_t)((3 * l + 3) & 1) * 16 * MTOK : nullptr, 0.5f};
          pg8::gemm_phase<pg8::EpiRes, pg8::StaticOrder, true, true>(lds, g, S, E, tl); }
        }
        if (ph + 1 < 9 * NLAYER) GRID_SYNC();
    }
}

extern "C" void kernel_launch(void* const* d_in, const int* in_sizes, int n_in, void* d_out, int out_size, void* d_ws, size_t ws_size, hipStream_t stream) {
    static int grid = 0;
    if (grid == 0) {
        if (n_in != 23 || out_size != MTOK * DM || ws_size < WS_END) { fprintf(stderr, "kernel_launch: unexpected problem (n_in %d out %d ws %zu)\n", n_in, out_size, ws_size); grid = -1; return; }
        int dev = 0, cus = 0, per_cu = 0;
        if (hipGetDevice(&dev) != hipSuccess || hipDeviceGetAttribute(&cus, hipDeviceAttributeMultiprocessorCount, dev) != hipSuccess) { grid = -1; return; }
        if (hipFuncSetAttribute((const void*)fwd_megakernel, hipFuncAttributeMaxDynamicSharedMemorySize, LDS_BYTES) != hipSuccess) { fprintf(stderr, "kernel_launch: hipFuncSetAttribute failed\n"); grid = -1; return; }
        if (hipOccupancyMaxActiveBlocksPerMultiprocessor(&per_cu, (const void*)fwd_megakernel, 512, LDS_BYTES) != hipSuccess || per_cu < 1) { fprintf(stderr, "kernel_launch: occupancy query gave %d\n", per_cu); per_cu = 1; }
        (void)hipGetLastError();
        grid = cus * per_cu;
    }
    if (grid < 0) return;
    if (hipMemsetAsync((char*)d_ws + WS_BAR, 0, BAR_BYTES, stream) != hipSuccess) { fprintf(stderr, "kernel_launch: memset of the barrier words failed\n"); return; }
    Args a{};
    for (int i = 0; i < 23; ++i) a.in[i] = (const float*)d_in[i];
    a.out = (float*)d_out; a.ws = (unsigned char*)d_ws;
    void* args[] = {&a};
    hipError_t e = hipLaunchCooperativeKernel((const void*)fwd_megakernel, dim3(grid), dim3(512), args, LDS_BYTES, stream);
    if (e != hipSuccess) fprintf(stderr, "kernel_launch: cooperative launch failed: %s (grid %d)\n", hipGetErrorString(e), grid);
}
```
